# Optimizing an MI355X kernel written in HIP

```python
import math
import jax, jax.numpy as jnp
from jax import lax
import numpy as np

D_MODEL = 2048
BATCH = 4
SEQ = 2048
DEPTH = 2

D_FF = 5632
N_MOD = 9
NORM_EPS = 1e-6

ATTN_HEADS = 8
ATTN_HEAD_DIM = 64
ATTN_WIDTH = ATTN_HEADS * ATTN_HEAD_DIM
IDX_HEADS = 16
IDX_DIM = 64
TOPK_MAX = 256
Q_BLOCK = 128
ROPE_THETA = 10000.0

RWKV_HEADS = 12
RWKV_HEAD_DIM = 64
RWKV_WIDTH = RWKV_HEADS * RWKV_HEAD_DIM
DECAY_LORA = 64
AAA_LORA = 64
MV_LORA = 32
GATE_LORA = 128
RWKV_LN_EPS = 64e-5

SSM_HEADS = 12
SSM_HEAD_DIM = 64
SSM_WIDTH = SSM_HEADS * SSM_HEAD_DIM
SSM_GROUPS = 4
SSM_STATE = 128
SSM_CONV = 4
SSM_CHUNK = 256
SSM_CONV_DIM = SSM_WIDTH + 2 * SSM_GROUPS * SSM_STATE
SSM_NORM_EPS = 1e-5

ATTN_SPLITS = (ATTN_WIDTH, ATTN_WIDTH, ATTN_WIDTH, IDX_HEADS * IDX_DIM, IDX_DIM, IDX_HEADS)
RWKV_SPLITS = (RWKV_WIDTH, RWKV_WIDTH, RWKV_WIDTH, DECAY_LORA, AAA_LORA, GATE_LORA)
SSM_SPLITS = (SSM_WIDTH, SSM_CONV_DIM, SSM_HEADS)
ATTN_COLS = sum(ATTN_SPLITS)
RWKV_COLS = sum(RWKV_SPLITS)
SSM_COLS = sum(SSM_SPLITS)
D_IN = ATTN_COLS + RWKV_COLS + SSM_COLS
D_MIX = ATTN_WIDTH + RWKV_WIDTH + SSM_WIDTH

kernel_name = 'hymba_dsa_rwkv7_mamba2_macaron_adaln'


def _split(u, sizes):
    return jnp.split(u, np.cumsum(sizes)[:-1].tolist(), axis=-1)


def rmsnorm(x, g):
    xf = x.astype(jnp.float32)
    y = xf * lax.rsqrt(jnp.mean(xf * xf, axis=-1, keepdims=True) + NORM_EPS)
    return (y * g.astype(jnp.float32)).astype(x.dtype)


def modulate(h, shift, scale):
    return h * (1.0 + scale) + shift


def swiglu(h, w_gate, w_up, w_down):
    return (jax.nn.silu(h @ w_gate) * (h @ w_up)) @ w_down


def rope(x, pos):
    half = x.shape[-1] // 2
    inv = ROPE_THETA ** (-jnp.arange(half, dtype=jnp.float32) / half)
    ang = pos.astype(jnp.float32)[..., None] * inv
    cos = jnp.cos(ang)[:, :, None, :]
    sin = jnp.sin(ang)[:, :, None, :]
    xf = x.astype(jnp.float32)
    x1, x2 = xf[..., :half], xf[..., half:]
    return jnp.concatenate([x1 * cos - x2 * sin, x2 * cos + x1 * sin], axis=-1).astype(x.dtype)


def dsa_attention(q, k, v, iq, ik, iw):
    B, T, H, hd = q.shape
    nb = T // Q_BLOCK
    top_k = min(TOPK_MAX, T // 4)
    key_pos = jnp.arange(T)
    gather = jax.vmap(lambda a, i: a[i])

    def to_blocks(a):
        return jnp.moveaxis(a.reshape((B, nb, Q_BLOCK) + a.shape[2:]), 1, 0)

    def one_block(args):
        qb, iqb, iwb, start = args
        q_pos = start + jnp.arange(Q_BLOCK)
        s = jnp.einsum('bqhd,bsd->bqhs', iqb, ik).astype(jnp.float32) * IDX_DIM ** -0.5
        score = jnp.einsum('bqhs,bqh->bqs', jax.nn.relu(s), iwb.astype(jnp.float32))
        causal = key_pos[None, :] <= q_pos[:, None]
        score = jnp.where(causal[None], score, -jnp.inf)
        _, idx = lax.top_k(score, top_k)
        valid = idx <= q_pos[None, :, None]
        k_sel = gather(k, idx)
        v_sel = gather(v, idx)
        logits = jnp.einsum('bqhd,bqkhd->bhqk', qb, k_sel).astype(jnp.float32) * hd ** -0.5
        logits = jnp.where(valid[:, None], logits, -jnp.inf)
        p = jax.nn.softmax(logits, axis=-1).astype(v.dtype)
        return jnp.einsum('bhqk,bqkhd->bqhd', p, v_sel)

    starts = jnp.arange(nb) * Q_BLOCK
    out = lax.map(one_block, (to_blocks(q), to_blocks(iq), to_blocks(iw), starts))
    return jnp.moveaxis(out, 0, 1).reshape(B, T, H * hd)


def rwkv7_scan(r, w, k, v, a, b):
    B, T, H, N = r.shape

    def step(S, inp):
        r_t, w_t, k_t, v_t, a_t, b_t = inp
        sa = jnp.einsum('bhij,bhj->bhi', S, a_t)
        S = S * w_t[:, :, None, :] + sa[..., None] * b_t[:, :, None, :] + v_t[..., None] * k_t[:, :, None, :]
        return S, jnp.einsum('bhij,bhj->bhi', S, r_t)

    xs = tuple(jnp.moveaxis(t, 1, 0) for t in (r, w, k, v, a, b))
    _, ys = lax.scan(step, jnp.zeros((B, H, N, N), jnp.float32), xs)
    return jnp.moveaxis(ys, 0, 1)


def rwkv7_time_mix(u, v_first, mu, w0, w2, a0, a2, g2, k_k, k_a, r_k, ln_w, ln_b, v_gate):
    B, T, _ = u.shape
    H, N = RWKV_HEADS, RWKV_HEAD_DIM
    prev = jnp.pad(u, ((0, 0), (1, 0), (0, 0)))[:, :-1]
    u = u + (prev - u) * mu
    r, k, v, wl, al, gl = _split(u, RWKV_SPLITS)
    w_log = -jax.nn.softplus(-(w0 + jnp.tanh(wl) @ w2)) - 0.5
    decay = jnp.exp(-jnp.exp(w_log.astype(jnp.float32)))
    a = jax.nn.sigmoid(a0 + al @ a2)
    g = jax.nn.sigmoid(gl) @ g2
    if v_gate is None:
        v_first = v
    else:
        v0, v1, v2 = v_gate
        v = v + (v_first - v) * jax.nn.sigmoid(v0 + (v @ v1) @ v2)
    hs = lambda t: t.reshape(B, T, H, N).astype(jnp.float32)
    kk = hs(k * k_k)
    kk = kk / jnp.maximum(jnp.sqrt(jnp.sum(kk * kk, axis=-1, keepdims=True)), 1e-12)
    k = k * (1.0 + (a - 1.0) * k_a)
    rh, kh, vh, ah = hs(r), hs(k), hs(v), hs(a)
    y = rwkv7_scan(rh, decay.reshape(B, T, H, N), kh, vh, -kk, kk * ah)
    mean = jnp.mean(y, axis=-1, keepdims=True)
    var = jnp.mean(jnp.square(y - mean), axis=-1, keepdims=True)
    y = ((y - mean) * lax.rsqrt(var + RWKV_LN_EPS)).reshape(B, T, RWKV_WIDTH)
    y = y * ln_w + ln_b
    bonus = jnp.sum(rh * kh * r_k, axis=-1, keepdims=True) * vh
    y = (y + bonus.reshape(B, T, RWKV_WIDTH)).astype(u.dtype) * g
    return y, v_first


def causal_dwconv(x, w, b):
    K = w.shape[-1]
    T = x.shape[1]
    xp = jnp.pad(x, ((0, 0), (K - 1, 0), (0, 0)))
    y = b
    for j in range(K):
        y = y + xp[:, j:j + T] * w[:, j]
    return y


def segsum(x):
    L = x.shape[-1]
    xe = jnp.broadcast_to(x[..., None], x.shape + (L,))
    xe = jnp.where(jnp.tril(jnp.ones((L, L), bool), -1), xe, 0.0)
    cs = jnp.cumsum(xe, axis=-2)
    return jnp.where(jnp.tril(jnp.ones((L, L), bool), 0), cs, -jnp.inf)


def ssd(X, A, Bm, Cm, chunk):
    b, T, h, p = X.shape
    c = T // chunk
    X, Bm, Cm = (t.reshape((b, c, chunk) + t.shape[2:]) for t in (X, Bm, Cm))
    A = jnp.moveaxis(A.reshape(b, c, chunk, h), 3, 1)
    A_cs = jnp.cumsum(A, axis=-1)
    L = jnp.exp(segsum(A))
    CB = jnp.einsum('bclhn,bcshn->bhcls', Cm, Bm)
    Y_diag = jnp.einsum('bhcls,bcshp->bclhp', CB * L, X)
    decay_states = jnp.exp(A_cs[..., -1:] - A_cs)
    states = jnp.einsum('bclhn,bhcl,bclhp->bchpn', Bm, decay_states, X)
    states = jnp.concatenate([jnp.zeros_like(states[:, :1]), states], axis=1)
    decay_chunk = jnp.exp(segsum(jnp.pad(A_cs[..., -1], ((0, 0), (0, 0), (1, 0)))))
    states = jnp.einsum('bhzc,bchpn->bzhpn', decay_chunk, states)[:, :-1]
    Y_off = jnp.einsum('bclhn,bchpn,bhcl->bclhp', Cm, states, jnp.exp(A_cs))
    return (Y_diag + Y_off).reshape(b, T, h, p)


def mamba2_mix(u, conv_w, conv_b, dt_bias, a_log, d_skip, norm_w):
    B, T, _ = u.shape
    z, xbc, dt = _split(u, SSM_SPLITS)
    xbc = jax.nn.silu(causal_dwconv(xbc, conv_w, conv_b))
    xs, Bm, Cm = _split(xbc, (SSM_WIDTH, SSM_GROUPS * SSM_STATE, SSM_GROUPS * SSM_STATE))
    xs = xs.reshape(B, T, SSM_HEADS, SSM_HEAD_DIM).astype(jnp.float32)
    rep = SSM_HEADS // SSM_GROUPS
    Bm = jnp.repeat(Bm.reshape(B, T, SSM_GROUPS, SSM_STATE), rep, axis=2).astype(jnp.float32)
    Cm = jnp.repeat(Cm.reshape(B, T, SSM_GROUPS, SSM_STATE), rep, axis=2).astype(jnp.float32)
    dt = jax.nn.softplus((dt + dt_bias).astype(jnp.float32))
    A = -jnp.exp(a_log.astype(jnp.float32))
    chunk = SSM_CHUNK if T % SSM_CHUNK == 0 else Q_BLOCK
    y = ssd(xs * dt[..., None], A * dt, Bm, Cm, chunk) + xs * d_skip.astype(jnp.float32)[:, None]
    y = y.reshape(B, T, SSM_WIDTH) * jax.nn.silu(z.astype(jnp.float32))
    yg = y.reshape(B, T, SSM_GROUPS, SSM_WIDTH // SSM_GROUPS)
    yg = yg * lax.rsqrt(jnp.mean(yg * yg, axis=-1, keepdims=True) + SSM_NORM_EPS)
    return (yg.reshape(B, T, SSM_WIDTH) * norm_w).astype(u.dtype)


def setup_inputs(seed: int = 0) -> dict:
    key = jax.random.key(seed)
    ks = iter(jax.random.split(key, 40))

    def nrm(shape, scale):
        return jax.random.normal(next(ks), shape, jnp.float32) * scale

    def unif(shape, lo, hi):
        return jax.random.uniform(next(ks), shape, jnp.float32, minval=lo, maxval=hi)

    L, Lv = DEPTH, max(DEPTH - 1, 1)
    offsets = jax.random.randint(next(ks), (BATCH,), 0, 1024, dtype=jnp.int32)
    positions = offsets[:, None] + jnp.arange(SEQ, dtype=jnp.int32)[None, :]
    dt0 = jnp.exp(unif((L, SSM_HEADS), math.log(1e-3), math.log(1e-1)))
    return {
        'x': nrm((BATCH, SEQ, D_MODEL), 1.0),
        'c': nrm((BATCH, D_MODEL), 1.0),
        'positions': positions,
        'ada_w': nrm((L, D_MODEL, N_MOD * D_MODEL), 0.5 * D_MODEL ** -0.5),
        'ada_b': nrm((L, N_MOD * D_MODEL), 0.02),
        'norm_g': 1.0 + nrm((L, 3, D_MODEL), 0.05),
        'ffn_w_gate': nrm((L, 2, D_MODEL, D_FF), D_MODEL ** -0.5),
        'ffn_w_up': nrm((L, 2, D_MODEL, D_FF), D_MODEL ** -0.5),
        'ffn_w_down': nrm((L, 2, D_FF, D_MODEL), D_FF ** -0.5),
        'w_in': nrm((L, D_MODEL, D_IN), D_MODEL ** -0.5),
        'w_out': nrm((L, D_MIX, D_MODEL), D_MIX ** -0.5),
        'rwkv_mu': unif((L, RWKV_COLS), 0.0, 1.0),
        'rwkv_w0': unif((L, RWKV_WIDTH), -5.0, 1.0),
        'rwkv_w2': nrm((L, DECAY_LORA, RWKV_WIDTH), 0.1 * DECAY_LORA ** -0.5),
        'rwkv_a0': nrm((L, RWKV_WIDTH), 0.1),
        'rwkv_a2': nrm((L, AAA_LORA, RWKV_WIDTH), 0.5 * AAA_LORA ** -0.5),
        'rwkv_g2': nrm((L, GATE_LORA, RWKV_WIDTH), GATE_LORA ** -0.5),
        'rwkv_k_k': 1.0 + nrm((L, RWKV_WIDTH), 0.1),
        'rwkv_k_a': 1.0 + nrm((L, RWKV_WIDTH), 0.1),
        'rwkv_r_k': nrm((L, RWKV_HEADS, RWKV_HEAD_DIM), 0.1),
        'rwkv_ln_w': 1.0 + nrm((L, RWKV_WIDTH), 0.05),
        'rwkv_ln_b': nrm((L, RWKV_WIDTH), 0.02),
        'rwkv_v0': nrm((Lv, RWKV_WIDTH), 0.5),
        'rwkv_v1': nrm((Lv, RWKV_WIDTH, MV_LORA), RWKV_WIDTH ** -0.5),
        'rwkv_v2': nrm((Lv, MV_LORA, RWKV_WIDTH), 0.5 * MV_LORA ** -0.5),
        'ssm_conv_w': nrm((L, SSM_CONV_DIM, SSM_CONV), SSM_CONV ** -0.5),
        'ssm_conv_b': nrm((L, SSM_CONV_DIM), 0.02),
        'ssm_dt_bias': dt0 + jnp.log(-jnp.expm1(-dt0)),
        'ssm_a_log': jnp.log(unif((L, SSM_HEADS), 1.0, 16.0)),
        'ssm_d': 1.0 + nrm((L, SSM_HEADS), 0.1),
        'ssm_norm_w': 1.0 + nrm((L, SSM_WIDTH), 0.05),
        'final_norm_g': 1.0 + nrm((D_MODEL,), 0.05),
    }


def reference(x, c, positions, ada_w, ada_b, norm_g, ffn_w_gate, ffn_w_up, ffn_w_down, w_in, w_out,
              rwkv_mu, rwkv_w0, rwkv_w2, rwkv_a0, rwkv_a2, rwkv_g2, rwkv_k_k, rwkv_k_a, rwkv_r_k,
              rwkv_ln_w, rwkv_ln_b, rwkv_v0, rwkv_v1, rwkv_v2, ssm_conv_w, ssm_conv_b, ssm_dt_bias,
              ssm_a_log, ssm_d, ssm_norm_w, final_norm_g):
    B, T, _ = x.shape
    cond = jax.nn.silu(c)
    v_first = None
    for l in range(DEPTH):
        mod = (cond @ ada_w[l] + ada_b[l])[:, None, :]
        sh1, sc1, gt1, shm, scm, gtm, sh2, sc2, gt2 = jnp.split(mod, N_MOD, axis=-1)

        h = modulate(rmsnorm(x, norm_g[l, 0]), sh1, sc1)
        x = x + 0.5 * gt1 * swiglu(h, ffn_w_gate[l, 0], ffn_w_up[l, 0], ffn_w_down[l, 0])

        h = modulate(rmsnorm(x, norm_g[l, 1]), shm, scm)
        u = h @ w_in[l]
        ua, ur, us = _split(u, (ATTN_COLS, RWKV_COLS, SSM_COLS))

        q, k, v, iq, ik, iw = _split(ua, ATTN_SPLITS)
        q = rope(q.reshape(B, T, ATTN_HEADS, ATTN_HEAD_DIM), positions)
        k = rope(k.reshape(B, T, ATTN_HEADS, ATTN_HEAD_DIM), positions)
        v = v.reshape(B, T, ATTN_HEADS, ATTN_HEAD_DIM)
        iq = rope(iq.reshape(B, T, IDX_HEADS, IDX_DIM), positions)
        ik = rope(ik[:, :, None, :], positions)[:, :, 0]
        y_attn = dsa_attention(q, k, v, iq, ik, iw * IDX_HEADS ** -0.5)

        v_gate = None if l == 0 else (rwkv_v0[l - 1], rwkv_v1[l - 1], rwkv_v2[l - 1])
        y_rwkv, v_first = rwkv7_time_mix(ur, v_first, rwkv_mu[l], rwkv_w0[l], rwkv_w2[l], rwkv_a0[l],
                                         rwkv_a2[l], rwkv_g2[l], rwkv_k_k[l], rwkv_k_a[l], rwkv_r_k[l],
                                         rwkv_ln_w[l], rwkv_ln_b[l], v_gate)

        y_ssm = mamba2_mix(us, ssm_conv_w[l], ssm_conv_b[l], ssm_dt_bias[l], ssm_a_log[l], ssm_d[l],
                           ssm_norm_w[l])

        y = jnp.concatenate([y_attn, y_rwkv, y_ssm], axis=-1) @ w_out[l]
        x = x + gtm * y

        h = modulate(rmsnorm(x, norm_g[l, 2]), sh2, sc2)
        x = x + 0.5 * gt2 * swiglu(h, ffn_w_gate[l, 1], ffn_w_up[l, 1], ffn_w_down[l, 1])
    return rmsnorm(x, final_norm_g)
```

```cpp
#include <hip/hip_runtime.h>
#include <cstdio>
#include <cstdint>
#include <cmath>
#include <hip/hip_bf16.h>
namespace pg8 {
#define PG8_LAS __attribute__((address_space(3)))
typedef unsigned short bf16_t;
typedef short bf16x8 __attribute__((ext_vector_type(8)));
typedef float f32x4 __attribute__((ext_vector_type(4)));
typedef unsigned u32x4 __attribute__((ext_vector_type(4)));
constexpr int BM = 256, BK = 64, HALF = 128, HTB = HALF * BK * 2  , STAGE_BYTES = 8 * HTB, NXCD = 8, WGM = 8;

__host__ __device__ __forceinline__ int lds_byte(int r, int c) { const int st = (r >> 4) * 2 + (c >> 5), rr = r & 15, cc = c & 31, ob = rr * 64 + cc * 2; return st * 1024 + (ob ^ (((ob >> 9) & 1) << 5)); }
__host__ __device__ __forceinline__ void stage_rc(int b, int& R, int& C) { const int st = b / 1024, sb = b % 1024, swz = sb ^ (((sb >> 9) & 1) << 5); R = (st >> 1) * 16 + swz / 64; C = (st & 1) * 32 + (swz % 64) / 2; }
__host__ __device__ __forceinline__ int perm32(int rho) { const int n = rho >> 4, i = rho & 15; return 8 * (i >> 2) + 4 * n + (i & 3); }

struct Unit { int pm, pn; };
struct Gemm { const bf16_t* A; const bf16_t* Bt; int M, N, K; };

struct StaticOrder {
    int nM, nN, nwg, G, c;
    __host__ __device__ void init(int M, int N, int G_, int c_) { nM = M / BM; nN = N / BM; nwg = nM * nN; G = G_; c = c_; }
    __host__ __device__ bool next(int i, Unit& u) const {
        const long L = (long)i * G + c; if (L >= nwg) return false;
        int wgid = (int)L; { const int q = nwg / NXCD, r = nwg % NXCD, xcd = wgid % NXCD, off = wgid / NXCD; wgid = (xcd < r ? xcd * (q + 1) : r * (q + 1) + (xcd - r) * q) + off; }
        const int nig = WGM * nN, gid = wgid / nig, fm = gid * WGM, gsz = (nM - fm) < WGM ? (nM - fm) : WGM;
        u.pm = fm + ((wgid % nig) % gsz); u.pn = (wgid % nig) / gsz; return true;
    }
    __device__ __forceinline__ void a_ready(const Unit&) const {}
    __device__ __forceinline__ void done(const Unit&) const {}
};

__device__ __forceinline__ unsigned cvt_pk_bf16(float lo, float hi) { unsigned r; asm volatile("v_cvt_pk_bf16_f32 %0, %1, %2" : "=v"(r) : "v"(lo), "v"(hi)); return r; }
typedef float f32x2 __attribute__((ext_vector_type(2)));

template <class Epi, class Sched, bool ALIGN_EPI = false, bool SP2 = false>
__device__ __forceinline__ void gemm_phase(PG8_LAS unsigned char* lds, const Gemm g, const Sched& S, const Epi& E, int tid_in) {
    int tid_ = tid_in; asm volatile("" : "+v"(tid_)); const int tid = tid_, wid = __builtin_amdgcn_readfirstlane(tid >> 6), lane = tid & 63, wr = wid >> 2, wc = wid & 3, fr = lane & 15, fq = lane >> 4;
    const int K = g.K, nt = K / BK;
    unsigned voffA[2], voffB[2];
#pragma unroll
    for (int i = 0; i < 2; ++i) { int R, C; stage_rc(tid * 16 + i * 8192, R, C); const int Rb = Epi::PERM ? ((R & ~31) + perm32(R & 31)) : R;
        voffA[i] = (unsigned)(R * K + C) * 2u; voffB[i] = (unsigned)(Rb * K + C) * 2u; }
    const size_t kstep = (size_t)(BK * 2);
    const size_t hstep = (size_t)HALF * K * 2;
    const size_t tstep = 2 * hstep;
    const unsigned ldsw = (unsigned)wid * 1024u;
    const int aoff = lds_byte(wr * 64 + fr, fq * 8), boff = lds_byte(wc * 32 + fr, fq * 8);
#define PG8_SA(b, h) (((b) * 2 + (h)) * HTB)
#define PG8_SB(b, h) ((4 + (b) * 2 + (h)) * HTB)
#define PG8_STAGE(bufoff, gbase, voff) do { _Pragma("unroll") for (int _i = 0; _i < 2; ++_i) \
        __builtin_amdgcn_global_load_lds((const unsigned*)((const char*)(gbase) + (voff)[_i]), (PG8_LAS unsigned*)(lds + (bufoff) + ldsw + _i * 8192), 16, 0, 0); } while (0)
#define PG8_LDA(dst, b, h) do { _Pragma("unroll") for (int m = 0; m < 4; ++m) _Pragma("unroll") for (int k = 0; k < 2; ++k) dst[m][k] = *(const PG8_LAS bf16x8*)(lds + PG8_SA(b, h) + aoff + m * 2048 + k * 1024); } while (0)
#define PG8_LDB(dst, b, h) do { _Pragma("unroll") for (int n = 0; n < 2; ++n) _Pragma("unroll") for (int k = 0; k < 2; ++k) dst[n][k] = *(const PG8_LAS bf16x8*)(lds + PG8_SB(b, h) + boff + n * 2048 + k * 1024); } while (0)
#define PG8_MMA(ai, bj, At, Bt) do { __builtin_amdgcn_s_setprio(1); _Pragma("unroll") for (int m = 0; m < 4; ++m) _Pragma("unroll") for (int n = 0; n < 2; ++n) _Pragma("unroll") for (int k = 0; k < 2; ++k) \
        acc[ai][bj][m][n] = __builtin_amdgcn_mfma_f32_16x16x32_bf16(Bt[n][k], At[m][k], acc[ai][bj][m][n], 0, 0, 0); __builtin_amdgcn_s_setprio(0); } while (0)
#define PG8_WAIT_V(n) asm volatile("s_waitcnt vmcnt(" #n ")" ::: "memory")
#define PG8_WAIT_L(n) asm volatile("s_waitcnt lgkmcnt(" #n ")" ::: "memory")
#define PG8_BAR __builtin_amdgcn_s_barrier()
#define PG8_SCHED __builtin_amdgcn_sched_barrier(0)
    Unit cur, nxt; int ui = 0;
    if (!S.next(0, cur)) return;
    f32x4 acc[2][2][4][2];
#pragma unroll
    for (int a = 0; a < 2; ++a)
#pragma unroll
        for (int b = 0; b < 2; ++b)
#pragma unroll
            for (int m = 0; m < 4; ++m)
#pragma unroll
                for (int n = 0; n < 2; ++n) acc[a][b][m][n] = (f32x4){0.f, 0.f, 0.f, 0.f};
    bf16x8 At[4][2], B0[2][2], B1[2][2];
    const char* cA = (const char*)g.A + (size_t)cur.pm * tstep; const char* cB = (const char*)g.Bt + (size_t)cur.pn * tstep;
    S.a_ready(cur);
    if constexpr (SP2) {
        PG8_STAGE(PG8_SB(0, 0), cB, voffB); PG8_STAGE(PG8_SB(0, 1), cB + hstep, voffB); PG8_STAGE(PG8_SA(0, 0), cA, voffA); PG8_STAGE(PG8_SA(0, 1), cA + hstep, voffA);
        if (wr == 1) PG8_BAR;
        PG8_WAIT_V(2); PG8_BAR;
        PG8_STAGE(PG8_SB(1, 0), cB + kstep, voffB); PG8_STAGE(PG8_SA(1, 0), cA + kstep, voffA); PG8_STAGE(PG8_SB(1, 1), cB + hstep + kstep, voffB);
        PG8_WAIT_V(6); PG8_BAR;
    } else {
        PG8_STAGE(PG8_SB(0, 0), cB, voffB); PG8_STAGE(PG8_SA(0, 0), cA, voffA); PG8_STAGE(PG8_SB(0, 1), cB + hstep, voffB); PG8_STAGE(PG8_SA(0, 1), cA + hstep, voffA);
        if (wr == 1) PG8_BAR;
        PG8_WAIT_V(4); PG8_BAR;
        PG8_STAGE(PG8_SB(1, 0), cB + kstep, voffB); PG8_STAGE(PG8_SA(1, 0), cA + kstep, voffA); PG8_STAGE(PG8_SB(1, 1), cB + hstep + kstep, voffB);
        PG8_WAIT_V(6); PG8_BAR;
    }
    for (;;) {
        const bool has_next = S.next(ui + 1, nxt);
        const char* nA = has_next ? (const char*)g.A + (size_t)nxt.pm * tstep : cA; const char* nB = has_next ? (const char*)g.Bt + (size_t)nxt.pn * tstep : cB;
        for (int t = 0; t < nt; t += 2) {
            const bool last = (t == nt - 2);
            const char* a1 = cA + (size_t)(t + 1) * kstep;
            const char* a2 = last ? nA : cA + (size_t)(t + 2) * kstep; const char* b2 = last ? nB : cB + (size_t)(t + 2) * kstep;
            const char* a3 = a2 + kstep; const char* b3 = b2 + kstep;
            if (last && has_next) S.a_ready(nxt);
            if constexpr (SP2) {
            PG8_LDB(B0, 0, 0); PG8_LDB(B1, 0, 1); PG8_SCHED; PG8_LDA(At, 0, 0); PG8_STAGE(PG8_SA(1, 1), a1 + hstep, voffA);
            PG8_WAIT_V(8); PG8_WAIT_L(0); PG8_BAR; PG8_MMA(0, 0, At, B0); PG8_MMA(0, 1, At, B1); PG8_BAR; PG8_SCHED;
            PG8_LDA(At, 0, 1); PG8_STAGE(PG8_SB(0, 0), b2, voffB); PG8_STAGE(PG8_SB(0, 1), b2 + hstep, voffB); PG8_STAGE(PG8_SA(0, 0), a2, voffA);
            PG8_WAIT_V(8); PG8_WAIT_L(0); PG8_BAR; PG8_MMA(1, 0, At, B0); PG8_MMA(1, 1, At, B1); PG8_BAR; PG8_SCHED;
            PG8_LDB(B0, 1, 0); PG8_LDB(B1, 1, 1); PG8_SCHED; PG8_LDA(At, 1, 0); PG8_STAGE(PG8_SA(0, 1), a2 + hstep, voffA);
            PG8_WAIT_V(8); PG8_WAIT_L(0); PG8_BAR; PG8_MMA(0, 0, At, B0); PG8_MMA(0, 1, At, B1); PG8_BAR; PG8_SCHED;
            PG8_LDA(At, 1, 1); PG8_STAGE(PG8_SB(1, 0), b3, voffB); PG8_STAGE(PG8_SB(1, 1), b3 + hstep, voffB); PG8_STAGE(PG8_SA(1, 0), a3, voffA);
            PG8_WAIT_V(8); PG8_WAIT_L(0); PG8_BAR; PG8_MMA(1, 0, At, B0); PG8_MMA(1, 1, At, B1); PG8_BAR; PG8_SCHED;
            } else {
            PG8_LDB(B0, 0, 0); PG8_SCHED; PG8_LDA(At, 0, 0); PG8_STAGE(PG8_SA(1, 1), a1 + hstep, voffA);
            PG8_WAIT_L(8); PG8_BAR; PG8_WAIT_L(0); PG8_MMA(0, 0, At, B0); PG8_BAR; PG8_SCHED;
            PG8_LDB(B1, 0, 1); PG8_STAGE(PG8_SB(0, 0), b2, voffB);
            PG8_BAR; PG8_WAIT_L(0); PG8_MMA(0, 1, At, B1); PG8_BAR;
            PG8_LDA(At, 0, 1); PG8_STAGE(PG8_SA(0, 0), a2, voffA);
            PG8_BAR; PG8_WAIT_L(0); PG8_MMA(1, 0, At, B0); PG8_BAR; PG8_SCHED;
            PG8_STAGE(PG8_SB(0, 1), b2 + hstep, voffB);
            PG8_WAIT_V(6); PG8_BAR; PG8_MMA(1, 1, At, B1); PG8_BAR;
            PG8_LDB(B0, 1, 0); PG8_SCHED; PG8_LDA(At, 1, 0); PG8_STAGE(PG8_SA(0, 1), a2 + hstep, voffA);
            PG8_WAIT_L(8); PG8_BAR; PG8_WAIT_L(0); PG8_MMA(0, 0, At, B0); PG8_BAR; PG8_SCHED;
            PG8_LDB(B1, 1, 1); PG8_STAGE(PG8_SB(1, 0), b3, voffB);
            PG8_BAR; PG8_WAIT_L(0); PG8_MMA(0, 1, At, B1); PG8_BAR;
            PG8_LDA(At, 1, 1); PG8_STAGE(PG8_SA(1, 0), a3, voffA);
            PG8_BAR; PG8_WAIT_L(0); PG8_MMA(1, 0, At, B0); PG8_BAR; PG8_SCHED;
            PG8_STAGE(PG8_SB(1, 1), b3 + hstep, voffB);
            PG8_WAIT_V(6); PG8_BAR; PG8_MMA(1, 1, At, B1); PG8_BAR;
            }
        }
        if constexpr (ALIGN_EPI) { if (wr == 0) PG8_BAR; }
        if constexpr (!Epi::AFTER_DRAIN) { E(acc, cur, wr, wc, fr, fq); S.done(cur); }
        if (!has_next) break;
#pragma unroll
        for (int a = 0; a < 2; ++a)
#pragma unroll
            for (int b = 0; b < 2; ++b)
#pragma unroll
                for (int m = 0; m < 4; ++m)
#pragma unroll
                    for (int n = 0; n < 2; ++n) acc[a][b][m][n] = (f32x4){0.f, 0.f, 0.f, 0.f};
        cur = nxt; cA = nA; cB = nB; ++ui;
        if constexpr (ALIGN_EPI) { if (wr == 1) PG8_BAR; }
    }
    PG8_WAIT_V(0);
    if constexpr (!ALIGN_EPI) { if (wr == 0) PG8_BAR; }
    PG8_BAR;
    if constexpr (Epi::AFTER_DRAIN) { E.fused(acc, cur, wr, wc, fr, fq, lds, wid, lane); S.done(cur); }
#undef PG8_SA
#undef PG8_SB
#undef PG8_STAGE
#undef PG8_LDA
#undef PG8_LDB
#undef PG8_MMA
#undef PG8_WAIT_V
#undef PG8_WAIT_L
#undef PG8_BAR
#undef PG8_SCHED
}
}
namespace pg8 {
__device__ __forceinline__ float silu_f(float g) { return g * __builtin_amdgcn_rcpf(1.0f + __builtin_amdgcn_exp2f(-1.4426950408889634f * g)); }
struct EpiSwiGLU {
    static constexpr bool PERM = true, AFTER_DRAIN = false;
    bf16_t* O; int ldc;
    __device__ __forceinline__ void operator()(const f32x4 (&acc)[2][2][4][2], const Unit& u, int wr, int wc, int fr, int fq) const {
        const int row0 = u.pm * BM + wr * 64 + fr, col0 = u.pn * HALF + wc * 32 + 8 * fq;
#pragma unroll
        for (int ai = 0; ai < 2; ++ai)
#pragma unroll
            for (int m = 0; m < 4; ++m) { bf16_t* rowp = O + (size_t)(row0 + ai * HALF + m * 16) * ldc + col0;
                const f32x4 g0 = acc[ai][0][m][0], g1 = acc[ai][0][m][1], u0 = acc[ai][1][m][0], u1 = acc[ai][1][m][1];
                f32x4 v0, v1;
#pragma unroll
                for (int j = 0; j < 4; ++j) { v0[j] = silu_f(g0[j]) * u0[j]; v1[j] = silu_f(g1[j]) * u1[j]; }
                u32x4 w; w.x = cvt_pk_bf16(v0[0], v0[1]); w.y = cvt_pk_bf16(v0[2], v0[3]); w.z = cvt_pk_bf16(v1[0], v1[1]); w.w = cvt_pk_bf16(v1[2], v1[3]);
                *(u32x4*)rowp = w; }
    }
};
struct EpiResid {
    static constexpr bool PERM = false, AFTER_DRAIN = false;
    const float* base; float* out; int ldc; const float* gate; float coef;
    __device__ __forceinline__ void operator()(const f32x4 (&acc)[2][2][4][2], const Unit& u, int wr, int wc, int fr, int fq) const {
        const int row0 = u.pm * BM + wr * 64 + fr, col0 = u.pn * BM + wc * 32 + 4 * fq;
        const float* gp = gate + (size_t)(u.pm >> 3) * 18432 + col0;
        f32x4 gv[2][2];
#pragma unroll
        for (int bj = 0; bj < 2; ++bj)
#pragma unroll
            for (int n = 0; n < 2; ++n) gv[bj][n] = *(const f32x4*)(gp + bj * HALF + n * 16) * coef;
#pragma unroll
        for (int ai = 0; ai < 2; ++ai)
#pragma unroll
            for (int m = 0; m < 4; ++m) { const size_t off = (size_t)(row0 + ai * HALF + m * 16) * ldc + col0;
#pragma unroll
                for (int bj = 0; bj < 2; ++bj)
#pragma unroll
                    for (int n = 0; n < 2; ++n) { const f32x4 bs = *(const f32x4*)(base + off + bj * HALF + n * 16); *(f32x4*)(out + off + bj * HALF + n * 16) = bs + acc[ai][bj][m][n] * gv[bj][n]; }
                asm volatile("" ::: "memory"); }
    }
};
typedef float f32x2p_ __attribute__((ext_vector_type(2))); typedef __bf16 bf16x2p_ __attribute__((ext_vector_type(2)));
__device__ __forceinline__ unsigned cvt_pk_vis(float lo, float hi) { f32x2p_ v = {lo, hi}; bf16x2p_ b = __builtin_convertvector(v, bf16x2p_); return __builtin_bit_cast(unsigned, b); }
struct EpiBf16U {
    static constexpr bool PERM = true, AFTER_DRAIN = false;
    bf16_t* O; int ldc;
    __device__ __forceinline__ void operator()(const f32x4 (&acc)[2][2][4][2], const Unit& u, int wr, int wc, int fr, int fq) const {
        const int row0 = u.pm * BM + wr * 64 + fr, col0 = u.pn * BM + wc * 32 + 8 * fq;
#pragma unroll
        for (int ai = 0; ai < 2; ++ai)
#pragma unroll
            for (int m = 0; m < 4; ++m) { bf16_t* rowp = O + (size_t)(row0 + ai * HALF + m * 16) * ldc + col0;
#pragma unroll
                for (int bj = 0; bj < 2; ++bj) { const f32x4 v0 = acc[ai][bj][m][0], v1 = acc[ai][bj][m][1];
                    u32x4 w; w.x = cvt_pk_vis(v0[0], v0[1]); w.y = cvt_pk_vis(v0[2], v0[3]); w.z = cvt_pk_vis(v1[0], v1[1]); w.w = cvt_pk_vis(v1[2], v1[3]);
                    *(u32x4*)(rowp + bj * HALF) = w; } }
    }
};
struct EpiF32 {
    static constexpr bool PERM = false, AFTER_DRAIN = false;
    float* C; int ldc;
    __device__ __forceinline__ void operator()(const f32x4 (&acc)[2][2][4][2], const Unit& u, int wr, int wc, int fr, int fq) const {
        const int row0 = u.pm * BM + wr * 64 + fr, col0 = u.pn * BM + wc * 32 + 4 * fq;
#pragma unroll
        for (int ai = 0; ai < 2; ++ai)
#pragma unroll
            for (int m = 0; m < 4; ++m) { float* rowp = C + (size_t)(row0 + ai * HALF + m * 16) * ldc + col0;
#pragma unroll
                for (int bj = 0; bj < 2; ++bj)
#pragma unroll
                    for (int n = 0; n < 2; ++n) *(f32x4*)(rowp + bj * HALF + n * 16) = acc[ai][bj][m][n]; }
    }
};
}

constexpr int NWAVES = 8, NTHR = 512;
constexpr int Bn = 4, T = 2048, D = 2048, M = Bn * T, FF = 5632, DIN = 7772, DINP = 7936, NMODC = 18432;
constexpr int AH = 8, AW = 512, TOPK = 256;
constexpr int RH = 12, RW = 768, RC = 2560;
constexpr int SH = 12, SW = 768, SG = 4, SCD = 1792;
constexpr int U_Q = 0, U_K = 512, U_V = 1024, U_IQ = 1536, U_IK = 2560, U_IW = 2624, U_RW = 2640, U_Z = 5200, U_XBC = 5968, U_DT = 7760;
constexpr float NORM_EPS = 1e-6f;

constexpr size_t MiB = 1u << 20;
constexpr size_t al256(size_t x) { return (x + 255) & ~(size_t)255; }
constexpr size_t WS_CTL = 0, CTL_ZERO_BYTES = 1 * MiB;
constexpr size_t WS_MOD = WS_CTL + CTL_ZERO_BYTES;
constexpr size_t WS_ROPC = al256(WS_MOD + (size_t)2 * 4 * NMODC * 4);
constexpr size_t WS_ROPS = al256(WS_ROPC + (size_t)M * 32 * 4);
constexpr size_t WS_WGU = al256(WS_ROPS + (size_t)M * 32 * 4);
constexpr size_t SZ_WGU = (size_t)2 * FF * D * 2;
constexpr size_t WS_WD = WS_WGU + 4 * SZ_WGU;
constexpr size_t SZ_WD = (size_t)D * FF * 2;
constexpr size_t WS_WIN = WS_WD + 4 * SZ_WD;
constexpr size_t SZ_WIN = (size_t)DINP * D * 2;
constexpr size_t WS_WOUT = WS_WIN + 2 * SZ_WIN;
constexpr size_t SZ_WOUT = (size_t)D * D * 2;
constexpr size_t WS_XW = WS_WOUT + 2 * SZ_WOUT;
constexpr size_t WS_H = WS_XW + (size_t)M * D * 4;
constexpr size_t WS_BIG = WS_H + (size_t)M * D * 2;
constexpr size_t WS_MIX = WS_BIG + (size_t)M * DINP * 4;
constexpr size_t MX_Q = WS_MIX, MX_K = MX_Q + (size_t)M * AW * 4, MX_IQ = MX_K + (size_t)M * AW * 4, MX_IK = MX_IQ + (size_t)M * 1024 * 4;
constexpr size_t MX_R = MX_IK + (size_t)M * 64 * 4, SZ_R = (size_t)M * RW * 4;
constexpr size_t MX_W = MX_R + SZ_R, MX_KK = MX_W + SZ_R, MX_V = MX_KK + SZ_R, MX_A = MX_V + SZ_R, MX_B = MX_A + SZ_R, MX_G = MX_B + SZ_R, MX_VF = MX_G + SZ_R, MX_YR = MX_VF + SZ_R;
constexpr size_t MX_XBC = MX_YR + SZ_R, MX_DT = MX_XBC + (size_t)M * SCD * 4, MX_YS = al256(MX_DT + (size_t)M * SH * 4);
constexpr size_t MX_YS2 = MX_YS + SZ_R;
constexpr size_t AT_Q = MX_YS2 + SZ_R;
constexpr size_t AT_K = AT_Q + (size_t)M * AW * 2, AT_V = AT_K + (size_t)M * AW * 2;
constexpr size_t AT_IQ = AT_V + (size_t)M * AW * 2;
constexpr size_t AT_IK = AT_IQ + (size_t)M * 1024 * 2;
constexpr size_t AT_IW = AT_IK + (size_t)M * 64 * 2;
constexpr size_t AT_MK = AT_IW + (size_t)M * 16 * 4;
constexpr size_t SS_B = AT_MK + (size_t)4 * 32 * 2048 * 8;
constexpr size_t SS_C = SS_B + (size_t)M * 512 * 2;
constexpr size_t SS_ST = SS_C + (size_t)M * 512 * 2;
constexpr size_t SS_CS = SS_ST + (size_t)4 * 12 * 8 * 64 * 128 * 4;
constexpr size_t SS_TOT = SS_CS + (size_t)M * 12 * 4;
constexpr size_t WS_LW = SS_TOT + 4096;
constexpr size_t LW_W2 = 0, LW_A2 = 768 * 64, LW_G2 = LW_A2 + 768 * 64, LW_V1 = LW_G2 + 768 * 128, LW_V2 = LW_V1 + 32 * 768, LW_ELEMS = LW_V2 + 768 * 32;
constexpr size_t WS_SSQ = al256(WS_LW + 2 * LW_ELEMS * 2);
constexpr size_t WS_END = WS_SSQ + (size_t)M * 8 * 4;
constexpr int CW_PCNT = 3072;
constexpr int CW_BAR = 4096;

constexpr int RING_OFF = 0, RING_BYTES = 131072;
constexpr int LDSCTL_OFF = RING_BYTES, MISC_OFF = LDSCTL_OFF + 320;
constexpr int LDS_BYTES = 147456;

#define GAS __attribute__((address_space(1)))
#define LAS __attribute__((address_space(3)))
typedef unsigned short bf16;
typedef unsigned v4u __attribute__((ext_vector_type(4)));
typedef unsigned v2u __attribute__((ext_vector_type(2)));
typedef float f32x4 __attribute__((ext_vector_type(4)));
typedef float f32x2 __attribute__((ext_vector_type(2)));
#define LDS_WAIT() asm volatile("s_waitcnt lgkmcnt(0)" ::: "memory")
#define VM_WAIT() asm volatile("s_waitcnt vmcnt(0)" ::: "memory")
__device__ __forceinline__ unsigned f2bf(float f) { unsigned u = __builtin_bit_cast(unsigned, f); return (u + 0x7fffu + ((u >> 16) & 1u)) >> 16; }
__device__ __forceinline__ unsigned pk2(float lo, float hi) { return f2bf(lo) | (f2bf(hi) << 16); }
__device__ __forceinline__ f32x4 ld4bf(const bf16* p) { const v2u w = *(const GAS v2u*)p; f32x4 r; r[0] = __builtin_bit_cast(float, w.x << 16); r[1] = __builtin_bit_cast(float, w.x & 0xffff0000u); r[2] = __builtin_bit_cast(float, w.y << 16); r[3] = __builtin_bit_cast(float, w.y & 0xffff0000u); return r; }
__device__ __forceinline__ f32x4 cvt4bf(const v2u w) { f32x4 r; r[0] = __builtin_bit_cast(float, w.x << 16); r[1] = __builtin_bit_cast(float, w.x & 0xffff0000u); r[2] = __builtin_bit_cast(float, w.y << 16); r[3] = __builtin_bit_cast(float, w.y & 0xffff0000u); return r; }
__device__ __forceinline__ float bf2f(bf16 b) { return __builtin_bit_cast(float, (unsigned)b << 16); }
__device__ __forceinline__ float fexp_(float x) { return __builtin_amdgcn_exp2f(x * 1.4426950408889634f); }
__device__ __forceinline__ float frcp_(float x) { return __builtin_amdgcn_rcpf(x); }
__device__ __forceinline__ float sigmoidf_(float x) { return frcp_(1.f + fexp_(-x)); }
__device__ __forceinline__ float siluf_(float x) { return x * frcp_(1.f + fexp_(-x)); }
__device__ __forceinline__ float softplusf_(float x) { return fmaxf(x, 0.f) + __builtin_amdgcn_logf(1.f + fexp_(-fabsf(x))) * 0.6931471805599453f; }
__device__ __forceinline__ float ftanh_(float x) { const float e = fexp_(2.f * fminf(fmaxf(x, -15.f), 15.f)); return (e - 1.f) * frcp_(e + 1.f); }

#define XB_TMO      128
#define XB_XCNT(j)  (256  + 64 * (j))
#define XB_XSUB(j)  (1280 + 64 * (j))
#define XB_XGEN(j)  (2304 + 64 * (j))
#define XB_TOP      3328
#define XB_TOPGEN   3392
#define XCD_BAR_WORDS 3456
#define XB_SPIN_CAP (1u << 21)

__device__ __forceinline__ unsigned xb_ld(unsigned* p)              { return __hip_atomic_load(p, __ATOMIC_RELAXED, __HIP_MEMORY_SCOPE_AGENT); }
__device__ __forceinline__ unsigned xb_add(unsigned* p, unsigned v) { return __hip_atomic_fetch_add(p, v, __ATOMIC_RELAXED, __HIP_MEMORY_SCOPE_AGENT); }
__device__ __forceinline__ unsigned xb_xcc_id() { return (unsigned)__builtin_amdgcn_s_getreg((3 << 11) | 20) & 0xFu; }
#define XB_SPIN(cond, bar) do { unsigned _sp = 0; while (cond) { __builtin_amdgcn_s_sleep(1); \
    if ((++_sp & 255u) == 0u) { if (xb_ld(&(bar)[XB_TMO])) break; if (_sp > XB_SPIN_CAP) { atomicAdd(&(bar)[XB_TMO], 1u); break; } } } } while (0)

struct XcdBarrier {
    unsigned* bar; unsigned x;
    volatile LAS unsigned* st;
};

__device__ __forceinline__ XcdBarrier xcd_barrier_post(unsigned* bar, volatile LAS unsigned* st, int tid) {
    XcdBarrier b; b.bar = bar; b.x = xb_xcc_id(); b.st = st;
    if (tid == 0) (void)xb_add(&bar[XB_XCNT(b.x)], 1u);
    return b;
}
__device__ __forceinline__ void xcd_barrier_complete(unsigned* bar, unsigned x, unsigned& nloc, unsigned& nx) {
    const unsigned G = gridDim.x * gridDim.y * gridDim.z;
    unsigned sum, cnt, mine, sp = 0u;
    for (;;) {
        sum = 0u; cnt = 0u; mine = 0u;
#pragma unroll
        for (unsigned j = 0; j < 16; ++j) { const unsigned c = xb_ld(&bar[XB_XCNT(j)]); sum += c; cnt += (c > 0u) ? 1u : 0u; mine = (j == x) ? c : mine; }
        if (sum == G) break;
        __builtin_amdgcn_s_sleep(1);
        if ((++sp & 255u) == 0u) { if (xb_ld(&bar[XB_TMO])) break; if (sp > XB_SPIN_CAP) { atomicAdd(&bar[XB_TMO], 1u); break; } }
    }
    nloc = mine > 0u ? mine : 1u; nx = cnt > 0u ? cnt : 1u;
}

__device__ __forceinline__ void xcd_barrier(const XcdBarrier& b, int tid) {
    asm volatile("s_waitcnt vmcnt(0)" ::: "memory");
    __syncthreads();
    if (tid == 0) {
        unsigned* bar = b.bar; asm volatile("" : "+s"(bar));
        __builtin_amdgcn_s_waitcnt(0);
        unsigned nloc = b.st[0], nx = b.st[1];
        if (nloc == 0u) { xcd_barrier_complete(bar, b.x, nloc, nx); b.st[0] = nloc; b.st[1] = nx; }
        const unsigned old = xb_add(&bar[XB_XSUB(b.x)], 1u);
        const unsigned gen = old / nloc;
        if (old + 1u == (gen + 1u) * nloc) {
            __builtin_amdgcn_fence(__ATOMIC_RELEASE, "agent");
            asm volatile("s_waitcnt vmcnt(0)" ::: "memory");
            const unsigned og = xb_add(&bar[XB_TOP], 1u);
            const unsigned tg = og / nx;
            if (og + 1u == (tg + 1u) * nx) xb_add(&bar[XB_TOPGEN], 1u);
            else XB_SPIN(xb_ld(&bar[XB_TOPGEN]) == tg, bar);
            __builtin_amdgcn_fence(__ATOMIC_ACQUIRE, "agent");
            xb_add(&bar[XB_XGEN(b.x)], 1u);
            asm volatile("s_waitcnt vmcnt(0)" ::: "memory");
        } else {
            XB_SPIN(xb_ld(&bar[XB_XGEN(b.x)]) == gen, bar);
            __builtin_amdgcn_fence(__ATOMIC_ACQUIRE, "agent");
            asm volatile("s_waitcnt vmcnt(0)" ::: "memory");
        }
    }
    __syncthreads();
}


__device__ __forceinline__ void group_barrier(unsigned* cnt, unsigned n, unsigned* tmo, int tid) {
    asm volatile("s_waitcnt vmcnt(0)" ::: "memory");
    __syncthreads();
    if (tid == 0) {
        __builtin_amdgcn_fence(__ATOMIC_RELEASE, "agent");
        asm volatile("s_waitcnt vmcnt(0)" ::: "memory");
        (void)__hip_atomic_fetch_add(cnt, 1u, __ATOMIC_RELAXED, __HIP_MEMORY_SCOPE_AGENT);
        unsigned sp = 0;
        while (__hip_atomic_load(cnt, __ATOMIC_RELAXED, __HIP_MEMORY_SCOPE_AGENT) < n) {
            __builtin_amdgcn_s_sleep(2);
            if ((++sp & 255u) == 0u) { if (__hip_atomic_load(tmo, __ATOMIC_RELAXED, __HIP_MEMORY_SCOPE_AGENT)) break; if (sp > (1u << 21)) { atomicAdd(tmo, 1u); break; } }
        }
        __builtin_amdgcn_fence(__ATOMIC_ACQUIRE, "agent");
        asm volatile("s_waitcnt vmcnt(0)" ::: "memory");
    }
    __syncthreads();
}

namespace attn_body {
using bf16=__hip_bfloat16;
using bf16x8=__attribute__((ext_vector_type(8)))short;
using s16x4=__attribute__((ext_vector_type(4)))short;
using f32x16=__attribute__((ext_vector_type(16)))float;
using u32x4=__attribute__((ext_vector_type(4)))unsigned;
constexpr int BATCH=4,NHEAD=8,SEQ=2048,D=64,DM=NHEAD*D,OPITCH=2048;
constexpr int NW=8,QBLK=32,QB=QBLK*NW,KVBLK=64,NQB=SEQ/QB;
constexpr int ATTN_PITCH=DM, ATTN_UNIT_ROWS=QB;
__device__ __forceinline__ int crow(int r,int hi){return (r&3)+8*(r>>2)+4*hi;}
#define SBAR() __builtin_amdgcn_sched_barrier(0)
__device__ __forceinline__ void cmask(f32x16&p0,f32x16&p1,int jb,int qrel,int hi){
  const float NEG=-INFINITY; int kb=64*jb+4*hi;
  #pragma unroll
  for(int r=0;r<16;++r){int kv=kb+(r&3)+8*(r>>2); if(kv>qrel)p0[r]=NEG; if(kv+32>qrel)p1[r]=NEG;}
}

constexpr int NSLOT=3, SLOTB=8192;
constexpr int LDS_K=0, LDS_V=NSLOT*SLOTB, LDS_WS=2*NSLOT*SLOTB, LDS_OST=LDS_WS+NW*64*4, LDS_BYTES=LDS_OST+NW*4096;
constexpr float C2=0.125f*1.4426950408889634f;
__device__ __forceinline__ void glds16(const void*gsrc,unsigned lds_dst){unsigned keep;
  asm volatile("s_mov_b32 %0, m0\n\ts_mov_b32 m0, %2\n\ts_nop 0\n\tglobal_load_lds_dwordx4 %1, off\n\ts_mov_b32 m0, %0":"=&s"(keep):"v"(gsrc),"s"(lds_dst):"memory");}
__device__ __forceinline__ float max3f(float a,float b,float c){float r;asm("v_max3_f32 %0, %1, %2, %3":"=v"(r):"v"(a),"v"(b),"v"(c));return r;}
__device__ __forceinline__ float max2f(float a,float b){float r;asm("v_max_f32_e32 %0, %1, %2":"=v"(r):"v"(a),"v"(b));return r;}
__device__ __forceinline__ float fadd_s(float a,float b){float r;asm("v_add_f32_e32 %0, %1, %2":"=v"(r):"v"(a),"v"(b));return r;}
__device__ __forceinline__ float fsub_s(float a,float b){float r;asm("v_sub_f32_e32 %0, %1, %2":"=v"(r):"v"(a),"v"(b));return r;}
typedef float f32x2_t __attribute__((ext_vector_type(2))); typedef __bf16 bf16x2_t __attribute__((ext_vector_type(2)));
__device__ __forceinline__ unsigned cvtpk_s(float lo,float hi){f32x2_t v={lo,hi};bf16x2_t b=__builtin_convertvector(v,bf16x2_t);return __builtin_bit_cast(unsigned,b);}
#define WAIT_BAR(N) asm volatile("s_waitcnt vmcnt(" #N ") lgkmcnt(0)\n\ts_barrier":::"memory")

__device__ __forceinline__ void qkt(f32x16&p0,f32x16&p1,const char*Kslot,const bf16x8*qr,const f32x16&negm,int r32,int hi){
  const char*kb=Kslot+hi*1024+r32*16;
  #pragma unroll
  for(int d0=0;d0<4;++d0){
    const bf16x8 b0=*reinterpret_cast<const bf16x8*>(kb+d0*2048);
    const bf16x8 b1=*reinterpret_cast<const bf16x8*>(kb+d0*2048+512);
    if(d0==0){p0=__builtin_amdgcn_mfma_f32_32x32x16_bf16(b0,qr[0],negm,0,0,0);p1=__builtin_amdgcn_mfma_f32_32x32x16_bf16(b1,qr[0],negm,0,0,0);}
    else{p0=__builtin_amdgcn_mfma_f32_32x32x16_bf16(b0,qr[d0],p0,0,0,0);p1=__builtin_amdgcn_mfma_f32_32x32x16_bf16(b1,qr[d0],p1,0,0,0);}}
}
typedef __attribute__((address_space(3))) const char* lds_cptr;
typedef short v4i16_t __attribute__((ext_vector_type(4)));
__device__ __forceinline__ void kload8(bf16x8*kf,lds_cptr kp){
  kf[0]=*(const __attribute__((address_space(3))) bf16x8*)(kp);      kf[1]=*(const __attribute__((address_space(3))) bf16x8*)(kp+512);
  kf[2]=*(const __attribute__((address_space(3))) bf16x8*)(kp+2048); kf[3]=*(const __attribute__((address_space(3))) bf16x8*)(kp+2560);
  kf[4]=*(const __attribute__((address_space(3))) bf16x8*)(kp+4096); kf[5]=*(const __attribute__((address_space(3))) bf16x8*)(kp+4608);
  kf[6]=*(const __attribute__((address_space(3))) bf16x8*)(kp+6144); kf[7]=*(const __attribute__((address_space(3))) bf16x8*)(kp+6656);
}
__device__ __forceinline__ void kload2(bf16x8*kf,lds_cptr kp,int j){ kf[2*j]=*(const __attribute__((address_space(3))) bf16x8*)(kp+j*2048); kf[2*j+1]=*(const __attribute__((address_space(3))) bf16x8*)(kp+j*2048+512); }
__device__ __forceinline__ s16x4 vtr(lds_cptr p){ return __builtin_bit_cast(s16x4,__builtin_amdgcn_ds_read_tr16_b64_v4i16((__attribute__((address_space(3))) v4i16_t*)p)); }
__device__ __forceinline__ float rowmax(const f32x16&p0,const f32x16&p1){
  float a=max3f(p0[0],p0[1],p1[0]),b=max3f(p0[2],p0[3],p1[1]);a=max3f(a,p1[2],p1[3]);
  #pragma unroll
  for(int r=4;r<16;r+=4){a=max3f(a,p0[r],p0[r+1]);b=max3f(b,p0[r+2],p0[r+3]);a=max3f(a,p1[r],p1[r+1]);b=max3f(b,p1[r+2],p1[r+3]);}
  const float m=max2f(a,b);
  auto rr=__builtin_amdgcn_permlane32_swap(__float_as_uint(m),__float_as_uint(m),false,false);
  return max2f(__uint_as_float(rr[0]),__uint_as_float(rr[1]));
}
__device__ __forceinline__ void pv(f32x16*o,int vb,bf16x8 pa0,bf16x8 pa1,bf16x8 pa2,bf16x8 pa3){
  #pragma unroll
  for(int d0=0;d0<2;++d0){s16x4 lo[4],hi[4];
    #pragma unroll
    for(int ks=0;ks<4;++ks){
      asm volatile("ds_read_b64_tr_b16 %0,%1 offset:%c2":"=&v"(lo[ks]):"v"(vb),"i"(d0*4096+ks*1024):"memory");
      asm volatile("ds_read_b64_tr_b16 %0,%1 offset:%c2":"=&v"(hi[ks]):"v"(vb),"i"(d0*4096+ks*1024+512):"memory");}
    asm volatile("s_waitcnt lgkmcnt(0)":::"memory");SBAR();
    #define PK(k) (bf16x8){lo[k][0],lo[k][1],lo[k][2],lo[k][3],hi[k][0],hi[k][1],hi[k][2],hi[k][3]}
    o[d0]=__builtin_amdgcn_mfma_f32_32x32x16_bf16(pa0,PK(0),o[d0],0,0,0);
    o[d0]=__builtin_amdgcn_mfma_f32_32x32x16_bf16(pa1,PK(1),o[d0],0,0,0);
    o[d0]=__builtin_amdgcn_mfma_f32_32x32x16_bf16(pa2,PK(2),o[d0],0,0,0);
    o[d0]=__builtin_amdgcn_mfma_f32_32x32x16_bf16(pa3,PK(3),o[d0],0,0,0);
    #undef PK
  }
}

#ifndef ATTN_STORE16
#define ATTN_STORE16(p,v) (*(u32x4*)(p)=(v))
#endif
__device__ __forceinline__ float mandf(float v,unsigned mw,int bit){ const int iv=__builtin_bit_cast(int,v); return __builtin_bit_cast(float,iv&__builtin_amdgcn_sbfe((int)mw,bit,1)); }
template<int THRL> __device__ __forceinline__ void attn_unit(int b,int h,int qb,const bf16*Q,const bf16*__restrict__ K,const bf16*__restrict__ V,bf16*O,const unsigned long long*MKb,char*shm,int tid_in){
  int tid_=tid_in; asm volatile("":"+v"(tid_)); const int tid=tid_,lane=tid&63,r32=lane&31,hi=lane>>5; const int wid=__builtin_amdgcn_readfirstlane(tid>>6);
  const long rowbase=(long)b*SEQ; const int q0=qb*QB;
  const bf16*Qw=Q+(rowbase+q0+wid*QBLK)*DM+h*D;
  const bf16*Kh=K+rowbase*DM+h*D,*Vh=V+rowbase*DM+h*D;
  const unsigned lds0=(unsigned)(uintptr_t)shm;
  float*wsf=(float*)(shm+LDS_WS)+wid*64;
  const bf16*ksrc=Kh+(long)lane*DM+wid*8;
  const bf16*vsrc=Vh+(long)(16*(wid&3)+(lane>>2))*DM+(wid>>2)*32+(lane&3)*8;
  const unsigned kdst=lds0+LDS_K+wid*1024, vdst=lds0+LDS_V+wid*1024;
  #define DMA_K(t,slot) glds16(ksrc+(long)(t)*KVBLK*DM,(unsigned)__builtin_amdgcn_readfirstlane(kdst+(slot)))
  #define DMA_V(t,slot) glds16(vsrc+(long)(t)*KVBLK*DM,(unsigned)__builtin_amdgcn_readfirstlane(vdst+(slot)))
  const int vb0=(int)(lds0+LDS_V)+((lane>>4)&1)*32+(lane&3)*8+(4*hi+((lane&15)>>2))*64;
  const char*Kbase=shm+LDS_K; bf16x8 kf[8];
  const lds_cptr shm3=(lds_cptr)shm; const lds_cptr kp0=shm3+LDS_K+hi*1024+r32*16; const lds_cptr vp0=shm3+LDS_V+((lane>>4)&1)*32+(lane&3)*8+(4*hi+((lane&15)>>2))*64;
  const int NT=(q0+QB)/KVBLK;
  const unsigned mvoff=(unsigned)(q0+wid*QBLK+r32)*8u; const int msh=4*hi;
  unsigned long long mk_c,mk_n,mk_0;
  #define MASK_LOAD(dst,tt) asm volatile("global_load_dwordx2 %0, %1, %2":"=v"(dst):"v"(mvoff),"s"(MKb+(long)(tt)*SEQ):"memory")
  #define MBIT(r) (((r)&3)+8*((r)>>2))
  #define MAND(x,mw,r) (x)=mandf((x),(mw),MBIT(r))
  MASK_LOAD(mk_0,0); MASK_LOAD(mk_c,1);
  DMA_K(0,0);DMA_V(0,0);DMA_K(1,SLOTB);
  bf16x8 qr[4];
  #pragma unroll
  for(int d0=0;d0<4;++d0)qr[d0]=*reinterpret_cast<const bf16x8*>(&Qw[(long)r32*DM+d0*16+hi*8]);
  float mhat=0.f,l_reg=0.f;f32x16 o[2];o[0]=f32x16{};o[1]=f32x16{};const f32x16 zero16=f32x16{};
  const int qrel=wid*QBLK+r32;
  #define CMASK(P0,P1,t) do{int jb_=(t)-(NT-4); if(jb_>=0)cmask(P0,P1,jb_,qrel,hi);}while(0)
  bool resc=false;
  #define START(P0,P1) do{ const float rm=rowmax(P0,P1); resc=false; \
    { const float dl=rm; mhat=fadd_s(mhat,dl); \
      _Pragma("unroll") for(int r=0;r<16;++r){P0[r]=fsub_s(P0[r],dl);P1[r]=fsub_s(P1[r],dl);} \
      } \
    _Pragma("unroll") for(int r=0;r<16;++r)P0[r]=__builtin_amdgcn_exp2f(P0[r]); }while(0)
  #define RESC() do{ if(resc){ asm volatile("s_waitcnt lgkmcnt(0)":::"memory"); \
      _Pragma("unroll") for(int d_=0;d_<2;++d_) _Pragma("unroll") for(int r=0;r<16;++r)o[d_][r]*=wsf[crow(r,hi)]; } }while(0)
  f32x16 pA0,pA1,pB0,pB1;
  int sl_prev=0,sl_cur=0,sl_next=SLOTB;
  #define ROT() do{sl_prev=sl_cur;sl_cur=sl_next;sl_next=(sl_next==(NSLOT-1)*SLOTB)?0:sl_next+SLOTB;}while(0)
  DMA_K(2,2*SLOTB);
  WAIT_BAR(3); asm volatile("":"+v"(mk_0),"+v"(mk_c));
  qkt(pA0,pA1,Kbase,qr,zero16,r32,hi);asm volatile("s_nop 15\n\ts_nop 7":"+v"(pA0),"+v"(pA1));CMASK(pA0,pA1,0);
  START(pA0,pA1);
  _Pragma("unroll") for(int r=0;r<16;++r)pA1[r]=__builtin_amdgcn_exp2f(pA1[r]);
  { const unsigned m0_=(unsigned)mk_0>>msh, m1_=(unsigned)(mk_0>>32)>>msh; _Pragma("unroll") for(int r=0;r<16;++r){ MAND(pA0[r],m0_,r); MAND(pA1[r],m1_,r);} }
  WAIT_BAR(0);
  DMA_K(3,0);DMA_V(1,SLOTB);
  ROT();
  kload8(kf,kp0+sl_cur);
  WAIT_BAR(2);
  s16x4 vlo[8],vhi[8]; u32x4 pw0,pw1,pw2,pw3;
  #define PKW(P,B) cvtpk_s(P[B],P[B+1])
  #define PAF(k) __builtin_bit_cast(bf16x8,pw##k)
  #define VFR(i) (bf16x8){vlo[i][0],vlo[i][1],vlo[i][2],vlo[i][3],vhi[i][0],vhi[i][1],vhi[i][2],vhi[i][3]}
  #define PIN(x) asm volatile("":"+v"(x))
  #define MX3(a,b,c) __builtin_fmaxf(__builtin_fmaxf((a),(b)),(c))
  #define GAPA(MF,A0,A1,A2,A3,W0,W1,PW) do{ MF; sacc+=A0; sacc+=A1; sacc+=A2; sacc+=A3; PIN(sacc); W0; W1; PIN(PW); SBAR(); }while(0)
  #define EX(v) __builtin_amdgcn_exp2f(v)
  #define GAPB(MF,X,B,MW) do{ MF; X[B]=EX(X[B]); X[B+1]=EX(X[B+1]); X[B+2]=EX(X[B+2]); X[B+3]=EX(X[B+3]); MAND(X[B],MW,B); MAND(X[B+1],MW,B+1); MAND(X[B+2],MW,B+2); MAND(X[B+3],MW,B+3); PIN(X); SBAR(); }while(0)
  #define VRD(i) do{ vlo[i]=vtr(vp_+(((i)>>2)*4096+((i)&3)*1024)); vhi[i]=vtr(vp_+(((i)>>2)*4096+((i)&3)*1024+512)); }while(0)
  #define KRD(G,j) do{ if(G){ kload2(kf,kp0+sl_next,j); SBAR(); } }while(0)
  #define STEP(C0,C1,P0,P1,t,GK,GV,GL) do{ SBAR(); \
    if((t)+1<NT){ MASK_LOAD(mk_n,(t)+1); } \
    const lds_cptr vp_=vp0+sl_prev; \
    VRD(0); SBAR(); float sacc=(P0[0]+P0[1]); \
    GAPA(C0=__builtin_amdgcn_mfma_f32_32x32x16_bf16(kf[0],qr[0],zero16,0,0,0), P0[2],P0[3],P0[4],P0[5],     pw0[0]=PKW(P0,0), pw0[1]=PKW(P0,2), pw0); \
    VRD(4); SBAR(); GAPA(C1=__builtin_amdgcn_mfma_f32_32x32x16_bf16(kf[1],qr[0],zero16,0,0,0), P0[6],P0[7],P0[8],P0[9],     pw0[2]=PKW(P0,4), pw0[3]=PKW(P0,6), pw0); \
    VRD(1); SBAR(); GAPA(C0=__builtin_amdgcn_mfma_f32_32x32x16_bf16(kf[2],qr[1],C0,0,0,0),   P0[10],P0[11],P0[12],P0[13], pw1[0]=PKW(P0,8), pw1[1]=PKW(P0,10), pw1); \
    VRD(5); SBAR(); GAPA(C1=__builtin_amdgcn_mfma_f32_32x32x16_bf16(kf[3],qr[1],C1,0,0,0),   P0[14],P0[15],P1[0],P1[1],   pw1[2]=PKW(P0,12),pw1[3]=PKW(P0,14), pw1); \
    VRD(2); SBAR(); GAPA(C0=__builtin_amdgcn_mfma_f32_32x32x16_bf16(kf[4],qr[2],C0,0,0,0),   P1[2],P1[3],P1[4],P1[5],     pw2[0]=PKW(P1,0), pw2[1]=PKW(P1,2), pw2); \
    VRD(6); SBAR(); GAPA(C1=__builtin_amdgcn_mfma_f32_32x32x16_bf16(kf[5],qr[2],C1,0,0,0),   P1[6],P1[7],P1[8],P1[9],     pw2[2]=PKW(P1,4), pw2[3]=PKW(P1,6), pw2); \
    VRD(3); SBAR(); GAPA(C0=__builtin_amdgcn_mfma_f32_32x32x16_bf16(kf[6],qr[3],C0,0,0,0),   P1[10],P1[11],P1[12],P1[13], pw3[0]=PKW(P1,8), pw3[1]=PKW(P1,10), pw3); \
    VRD(7); SBAR(); GAPA(C1=__builtin_amdgcn_mfma_f32_32x32x16_bf16(kf[7],qr[3],C1,0,0,0),   P1[14],P1[15],0.f,0.f,       pw3[2]=PKW(P1,12),pw3[3]=PKW(P1,14), pw3); \
    l_reg+=sacc; \
    if(GK){DMA_K((t)+3,sl_cur);} if(GV){DMA_V((t)+1,sl_next);} \
    _Pragma("unroll") for(int r=0;r<16;++r){C0[r]-=mhat;C1[r]-=mhat;} \
    CMASK(C0,C1,t); \
    const unsigned m0_=(unsigned)mk_c>>msh, m1_=(unsigned)(mk_c>>32)>>msh; \
    { float a=MX3(C0[0],C0[1],C1[0]),b=MX3(C0[2],C0[3],C1[1]); a=MX3(a,C1[2],C1[3]); \
      _Pragma("unroll") for(int r=4;r<16;r+=4){a=MX3(a,C0[r],C0[r+1]);b=MX3(b,C0[r+2],C0[r+3]);a=MX3(a,C1[r],C1[r+1]);b=MX3(b,C1[r+2],C1[r+3]);} \
      float rm=__builtin_fmaxf(a,b); { auto rr=__builtin_amdgcn_permlane32_swap(__float_as_uint(rm),__float_as_uint(rm),false,false); rm=__builtin_fmaxf(__uint_as_float(rr[0]),__uint_as_float(rr[1])); } \
      resc=false; \
      if(__builtin_expect(__any(rm>(float)THRL),0)){ const float dl=__builtin_fmaxf(rm,0.f); mhat+=dl; \
        _Pragma("unroll") for(int r=0;r<16;++r){C0[r]-=dl;C1[r]-=dl;} \
        const float f=__builtin_amdgcn_exp2f(-dl); l_reg*=f; if(hi==0)wsf[r32]=f; resc=true; } } \
    SBAR(); \
    GAPB(o[0]=__builtin_amdgcn_mfma_f32_32x32x16_bf16(PAF(0),VFR(0),o[0],0,0,0), C0,0,m0_); \
    GAPB(o[1]=__builtin_amdgcn_mfma_f32_32x32x16_bf16(PAF(0),VFR(4),o[1],0,0,0), C0,4,m0_); \
    KRD(GL,0); GAPB(o[0]=__builtin_amdgcn_mfma_f32_32x32x16_bf16(PAF(1),VFR(1),o[0],0,0,0), C0,8,m0_); \
    KRD(GL,1); GAPB(o[1]=__builtin_amdgcn_mfma_f32_32x32x16_bf16(PAF(1),VFR(5),o[1],0,0,0), C0,12,m0_); \
    KRD(GL,2); GAPB(o[0]=__builtin_amdgcn_mfma_f32_32x32x16_bf16(PAF(2),VFR(2),o[0],0,0,0), C1,0,m1_); \
    KRD(GL,3); GAPB(o[1]=__builtin_amdgcn_mfma_f32_32x32x16_bf16(PAF(2),VFR(6),o[1],0,0,0), C1,4,m1_); \
    GAPB(o[0]=__builtin_amdgcn_mfma_f32_32x32x16_bf16(PAF(3),VFR(3),o[0],0,0,0), C1,8,m1_); \
    GAPB(o[1]=__builtin_amdgcn_mfma_f32_32x32x16_bf16(PAF(3),VFR(7),o[1],0,0,0), C1,12,m1_); \
    }while(0)
  #define MROT() do{ asm volatile("":"+v"(mk_n)); mk_c=mk_n; }while(0)
  int t=1;
  #undef CMASK
  #define CMASK(P0,P1,t) do{}while(0)
  for(;t+5<NT;t+=2){
    STEP(pB0,pB1,pA0,pA1,t,true,true,true);     WAIT_BAR(2); MROT(); RESC(); ROT();
    STEP(pA0,pA1,pB0,pB1,t+1,true,true,true);   WAIT_BAR(2); MROT(); RESC(); ROT();
  }
  #undef CMASK
  #define CMASK(P0,P1,t) do{int jb_=(t)-(NT-4); if(jb_>=0)cmask(P0,P1,jb_,qrel,hi);}while(0)
  #define ENDW(tt) do{ if((tt)+3<NT){WAIT_BAR(2);} else if((tt)+2<NT){WAIT_BAR(1);} else {WAIT_BAR(0);} }while(0)
  for(;t+1<NT;t+=2){
    STEP(pB0,pB1,pA0,pA1,t,(t+3<NT),(t+1<NT),(t+1<NT));       ENDW(t);   MROT(); RESC(); ROT();
    STEP(pA0,pA1,pB0,pB1,t+1,(t+4<NT),(t+2<NT),(t+2<NT));     ENDW(t+1); MROT(); RESC(); ROT();
  }
  STEP(pB0,pB1,pA0,pA1,NT-1,false,false,false); RESC();
  { float sacc=pB0[0]+pB0[1]; _Pragma("unroll") for(int r=2;r<16;++r)sacc+=pB0[r]; _Pragma("unroll") for(int r=0;r<16;++r)sacc+=pB1[r]; l_reg+=sacc;
    pw0=(u32x4){PKW(pB0,0),PKW(pB0,2),PKW(pB0,4),PKW(pB0,6)};pw1=(u32x4){PKW(pB0,8),PKW(pB0,10),PKW(pB0,12),PKW(pB0,14)};pw2=(u32x4){PKW(pB1,0),PKW(pB1,2),PKW(pB1,4),PKW(pB1,6)};pw3=(u32x4){PKW(pB1,8),PKW(pB1,10),PKW(pB1,12),PKW(pB1,14)};
    SBAR(); pv(o,vb0+sl_cur,PAF(0),PAF(1),PAF(2),PAF(3)); }
  #undef PKW
  #undef PAF
  #undef VFR
  #undef PIN
  #undef MX3
  #undef GAPA
  #undef GAPB
  #undef EX
  #undef VRD
  #undef KRD
  #undef STEP
  #undef ENDW
  {auto rr=__builtin_amdgcn_permlane32_swap(__float_as_uint(l_reg),__float_as_uint(l_reg),false,false);l_reg=__uint_as_float(rr[0])+__uint_as_float(rr[1]);}
  if(hi==0)wsf[32+r32]=l_reg;asm volatile("s_waitcnt lgkmcnt(0)":::"memory");
  float rli[16];
  #pragma unroll
  for(int r=0;r<16;++r)rli[r]=__builtin_amdgcn_rcpf(wsf[32+crow(r,hi)]);
  bf16*Ow=O+(rowbase+q0+wid*QBLK)*OPITCH+h*D;
  { bf16*stg=(bf16*)(shm+LDS_OST)+wid*2048;
    #pragma unroll
    for(int r=0;r<16;++r){const int orow=crow(r,hi);
      #pragma unroll
      for(int d0=0;d0<2;++d0)stg[orow*64+d0*32+r32]=__float2bfloat16(o[d0][r]*rli[r]);}
    asm volatile("s_waitcnt lgkmcnt(0)":::"memory");
    #pragma unroll
    for(int i=0;i<4;++i){const int row=i*8+(lane>>3),ch=lane&7; const u32x4 v=*(const u32x4*)(stg+row*64+ch*8); ATTN_STORE16(Ow+(long)row*OPITCH+ch*8,v);} }
  asm volatile("s_waitcnt lgkmcnt(0)\n\ts_barrier":::"memory");
  #undef DMA_K
  #undef DMA_V
  #undef MASK_LOAD
  #undef MBIT
  #undef MAND
  #undef MROT
  #undef CMASK
  #undef START
  #undef RESC
  #undef ROT
}
constexpr int ATTN_LDS_BYTES=LDS_BYTES;
struct AttnTensors { const bf16* Q; const bf16* K; const bf16* V; bf16* O; const unsigned long long* MK; };
#undef SBAR
#undef WAIT_BAR
}

struct Args { const void* in[32]; float* out; unsigned char* ws; int ph_lo, ph_hi; };
struct Frame {
    LAS unsigned char* lds; char* ldsg; volatile LAS unsigned* MISC; unsigned* ctl;
    int tid, lane, wave, vcu, G;
};
template <int CTRL> __device__ __forceinline__ float dpp_f(float x) { return __builtin_bit_cast(float, __builtin_amdgcn_update_dpp(0, __builtin_bit_cast(int, x), CTRL, 0xf, 0xf, true)); }
template <int CTRL> __device__ __forceinline__ int dpp_i(int x) { return __builtin_amdgcn_update_dpp(0, x, CTRL, 0xf, 0xf, true); }
__device__ __forceinline__ float rdlane_f(float x, int l) { return __builtin_bit_cast(float, __builtin_amdgcn_readlane(__builtin_bit_cast(int, x), l)); }
__device__ __forceinline__ float swz16_f(float x) { return __builtin_bit_cast(float, __builtin_amdgcn_ds_swizzle(__builtin_bit_cast(int, x), 0x401F)); }
__device__ __forceinline__ int swz16_i(int x) { return __builtin_amdgcn_ds_swizzle(x, 0x401F); }
__device__ __forceinline__ float row16_sum(float x) {
    x += dpp_f<0xB1>(x);
    x += dpp_f<0x4E>(x);
    x += dpp_f<0x141>(x);
    x += dpp_f<0x140>(x);
    return x;
}
__device__ __forceinline__ float wave_sum(float v) {
    v = row16_sum(v); v += swz16_f(v);
    return __builtin_bit_cast(float, __builtin_amdgcn_readlane(__builtin_bit_cast(int, v), 0)) + __builtin_bit_cast(float, __builtin_amdgcn_readlane(__builtin_bit_cast(int, v), 32));
}
__device__ __forceinline__ void transpose_item(const float* W, int K, int N, bf16* WT, int k0, int n0, int dst_row0, LAS float* scr, int lane) {
    const int nn = n0 + (lane & 31); const bool ok = nn < N;
    const GAS float* src = (const GAS float*)(W + (size_t)(k0 + (lane >> 5)) * N + nn);
    float t[32];
#pragma unroll
    for (int i = 0; i < 32; ++i) t[i] = ok ? src[(size_t)(2 * i) * N] : 0.f;
#pragma unroll
    for (int i = 0; i < 32; ++i) scr[(2 * i + (lane >> 5)) * 33 + (lane & 31)] = t[i];
    LDS_WAIT(); asm volatile("" ::: "memory");
    const int c = lane & 7;
#pragma unroll
    for (int j = 0; j < 4; ++j) { const int n = (lane >> 3) + 8 * j; const LAS float* sp = scr + (8 * c) * 33 + n;
        v4u o; o.x = pk2(sp[0 * 33], sp[1 * 33]); o.y = pk2(sp[2 * 33], sp[3 * 33]); o.z = pk2(sp[4 * 33], sp[5 * 33]); o.w = pk2(sp[6 * 33], sp[7 * 33]);
        *(GAS v4u*)(WT + (size_t)(dst_row0 + n) * K + k0 + 8 * c) = o; }
    LDS_WAIT(); asm volatile("" ::: "memory");
}
__device__ inline void sincos_d(double x, double& s, double& c) {
    const double k = rint(x * 0.63661977236758134308);
    double r = x - k * 1.57079632679489655800e+00; r -= k * 6.12323399573676603587e-17;
    const double r2 = r * r;
    double sp = r * (1.0 + r2 * (-1.0 / 6 + r2 * (1.0 / 120 + r2 * (-1.0 / 5040 + r2 * (1.0 / 362880 + r2 * (-1.0 / 39916800 + r2 * (1.0 / 6227020800.0)))))));
    double cp = 1.0 + r2 * (-0.5 + r2 * (1.0 / 24 + r2 * (-1.0 / 720 + r2 * (1.0 / 40320 + r2 * (-1.0 / 3628800 + r2 * (1.0 / 479001600.0 + r2 * (-1.0 / 87178291200.0)))))));
    const long long q = (long long)k; const int m = (int)(((q % 4) + 4) % 4);
    if (m == 0) { s = sp; c = cp; } else if (m == 1) { s = cp; c = -sp; } else if (m == 2) { s = -sp; c = -cp; } else { s = -cp; c = sp; }
}

constexpr int CV_GU = (D / 64) * (FF / 32);
constexpr int CV_D = (FF / 64) * (D / 32);
constexpr int CV_IN = (D / 64) * (DINP / 32);
constexpr int CV_OUT = (D / 64) * (D / 32);
constexpr int CV_PER_L = 2 * (2 * CV_GU + CV_D) + CV_IN + CV_OUT;
__device__ __forceinline__ void convert_item(const Args& a, unsigned char* ws, int it, LAS float* scr, int lane) {
    const int l = it / CV_PER_L; int r = it % CV_PER_L;
    if (r < 2 * (2 * CV_GU + CV_D)) {
        const int f = r / (2 * CV_GU + CV_D); r %= (2 * CV_GU + CV_D);
        const size_t lf = (size_t)l * 2 + f;
        if (r < 2 * CV_GU) {
            const int s = r / CV_GU; r %= CV_GU;
            const float* W = (const float*)a.in[6 + s] + lf * (size_t)D * FF;
            const int kb = r / (FF / 32), nb = r % (FF / 32), n0 = nb * 32;
            transpose_item(W, D, FF, (bf16*)(ws + WS_WGU + lf * SZ_WGU), kb * 64, n0, 256 * (n0 >> 7) + 128 * s + (n0 & 127), scr, lane);
        } else {
            r -= 2 * CV_GU;
            const float* W = (const float*)a.in[8] + lf * (size_t)FF * D;
            const int kb = r / (D / 32), nb = r % (D / 32);
            transpose_item(W, FF, D, (bf16*)(ws + WS_WD + lf * SZ_WD), kb * 64, nb * 32, nb * 32, scr, lane);
        }
    } else {
        r -= 2 * (2 * CV_GU + CV_D);
        if (r < CV_IN) {
            const float* W = (const float*)a.in[9] + (size_t)l * D * DIN;
            const int kb = r / (DINP / 32), nb = r % (DINP / 32);
            transpose_item(W, D, DIN, (bf16*)(ws + WS_WIN + (size_t)l * SZ_WIN), kb * 64, nb * 32, nb * 32, scr, lane);
        } else {
            r -= CV_IN;
            const float* W = (const float*)a.in[10] + (size_t)l * D * D;
            const int kb = r / (D / 32), nb = r % (D / 32);
            transpose_item(W, D, D, (bf16*)(ws + WS_WOUT + (size_t)l * SZ_WOUT), kb * 64, nb * 32, nb * 32, scr, lane);
        }
    }
}
constexpr int CV_F = 2 * CV_GU + CV_D, CV_IO = CV_IN + CV_OUT, CV_ABC = CV_D + CV_OUT + CV_F + CV_IO + 2 * CV_GU, CV_SLOT = (CV_ABC + 2) / 3;
static_assert(CV_SLOT >= CV_D + CV_OUT && 2 * CV_SLOT >= CV_D + CV_OUT + CV_F, "layer 0's second down projection and the first FFN of layer 1 must be complete after slot 1");
__device__ __forceinline__ int deferred_item(int d) {
    if (d < CV_OUT) return 2 * CV_F + CV_IN + d;
    d -= CV_OUT;
    if (d < CV_D) return CV_F + 2 * CV_GU + d;
    d -= CV_D;
    if (d < CV_F) return CV_PER_L + d;
    if (d < CV_F + CV_IO) return CV_PER_L + 2 * CV_F + (d - CV_F);
    return CV_PER_L + CV_F + (d - CV_F - CV_IO);
}
__device__ __forceinline__ void convert_slot(Frame& F, const Args& a, unsigned char* ws, int slot, int bid) {
    LAS float* scr = (LAS float*)(F.lds + F.wave * 16384);
    int lane = F.lane; asm volatile("" : "+v"(lane));
    const int gw = (bid - 128) * NWAVES + F.wave;
    if (slot < 3) { const int d1 = (slot + 1) * CV_SLOT < CV_ABC ? (slot + 1) * CV_SLOT : CV_ABC;
        for (int d = slot * CV_SLOT + gw; d < d1; d += 128 * NWAVES) convert_item(a, ws, deferred_item(d), scr, lane); }
    else for (int d = gw; d < CV_D; d += 128 * NWAVES) convert_item(a, ws, CV_PER_L + CV_F + 2 * CV_GU + d, scr, lane);
}

__device__ __forceinline__ void p0_prologue(Frame& F, const Args& a) {
    unsigned char* ws = a.ws;
    {
        const float* c = (const float*)a.in[1]; const float* ada_w = (const float*)a.in[3]; const float* ada_b = (const float*)a.in[4];
        float* MOD = (float*)(ws + WS_MOD);
        LAS float* cond = (LAS float*)(F.lds);
        LAS float* red = (LAS float*)(F.lds + 32768);
        for (int i = F.tid; i < 4 * 2048; i += NTHR) { const int b = i >> 11, k = i & 2047; cond[k * 4 + b] = siluf_(c[i]); }
        __syncthreads();
        for (int it = blockIdx.x; it < 256; it += F.G) {
            const int l = it >> 7, n0 = (it & 127) * 144;
            const bool act = F.lane < 36;
            const float* w = ada_w + (size_t)l * D * NMODC + n0 + 4 * (act ? F.lane : 0);
            f32x4 acc[4] = {};
            const int kb = F.wave * 256;
            if (act) {
#pragma unroll 16
                for (int k = kb; k < kb + 256; ++k) { const f32x4 wv = *(const GAS f32x4*)(w + (size_t)k * NMODC); const f32x4 cv = *(const LAS f32x4*)(cond + k * 4);
#pragma unroll
                    for (int b = 0; b < 4; ++b) acc[b] += wv * cv[b]; }
#pragma unroll
                for (int b = 0; b < 4; ++b) *(LAS f32x4*)(red + (F.wave * 4 + b) * 144 + 4 * F.lane) = acc[b];
            }
            __syncthreads();
            for (int o = F.tid; o < 4 * 144; o += NTHR) { const int b = o / 144, n = o - b * 144; float s = ada_b[l * NMODC + n0 + n];
#pragma unroll
                for (int w8 = 0; w8 < 8; ++w8) s += red[(w8 * 4 + b) * 144 + n];
                MOD[((size_t)l * 4 + b) * NMODC + n0 + n] = s; }
            __syncthreads();
        }
    }
    {
        const int* pos = (const int*)a.in[2]; float* rc = (float*)(ws + WS_ROPC); float* rs = (float*)(ws + WS_ROPS);
        for (int gid = blockIdx.x * NTHR + F.tid; gid < M * 32; gid += F.G * NTHR) {
            const int m = gid >> 5, i = gid & 31;
            const float inv = (float)pow(10000.0, -(double)i / 32.0);
            const float ang = (float)pos[m] * inv;
            double s, c; sincos_d((double)ang, s, c);
            rc[gid] = (float)c; rs[gid] = (float)s;
        }
    }
    {
        for (int gid = blockIdx.x * NTHR + F.tid; gid < 2 * (int)LW_ELEMS; gid += F.G * NTHR) {
            const int l = gid / (int)LW_ELEMS; int e = gid % (int)LW_ELEMS; float v;
            if (e < (int)LW_A2) { const int n = e / 64, k = e % 64; v = ((const float*)a.in[13])[(size_t)l * 64 * RW + k * RW + n]; }
            else if (e < (int)LW_G2) { e -= LW_A2; const int n = e / 64, k = e % 64; v = ((const float*)a.in[15])[(size_t)l * 64 * RW + k * RW + n]; }
            else if (e < (int)LW_V1) { e -= LW_G2; const int n = e / 128, k = e % 128; v = ((const float*)a.in[16])[(size_t)l * 128 * RW + k * RW + n]; }
            else if (e < (int)LW_V2) { e -= LW_V1; const int n = e / 768, k = e % 768; v = ((const float*)a.in[23])[k * 32 + n]; }
            else { e -= LW_V2; const int n = e / 32, k = e % 32; v = ((const float*)a.in[24])[k * RW + n]; }
            ((bf16*)(ws + WS_LW))[gid] = (bf16)f2bf(v);
        }
    }
    {
        __syncthreads();
        LAS float* scr = (LAS float*)(F.lds + F.wave * 16384);
        const int gw = F.vcu * NWAVES + F.wave, NGW = F.G * NWAVES;
        for (int j = gw; j < CV_PER_L - CV_D - CV_OUT; j += NGW) convert_item(a, ws, j < CV_F + 2 * CV_GU ? j : j + CV_D, scr, F.lane);
    }
}

namespace pg8 {
template <bool FINAL, bool BASEF32> struct EpiResidNormT {
    static constexpr bool PERM = true, AFTER_DRAIN = true;
    const void* base; void* out; int ldc; const float* gate; float coef;
    const float* nw; const float* shift; const float* scale; bf16_t* Hn; float* ssq; unsigned* pcnt; unsigned* tmo;
    __device__ __forceinline__ void fused(f32x4 (&acc)[2][2][4][2], const Unit& u, int wr, int wc, int fr, int fq, LAS unsigned char* lds, int wid, int lane) const {
        const int tid = wid * 64 + lane;
        const int rowl0 = wr * 64 + fr, row0 = u.pm * BM + rowl0, col0 = u.pn * BM + wc * 32 + 8 * fq, b = u.pm >> 3;
        const float* gp = gate + (size_t)b * NMODC + col0;
        f32x4 gv[2][2], nwv[2][2], sc1[2][2], sh[2][2];
#pragma unroll
        for (int bj = 0; bj < 2; ++bj)
#pragma unroll
            for (int n = 0; n < 2; ++n) gv[bj][n] = *(const f32x4*)(gp + bj * HALF + n * 4) * coef;
        float p[8];
#pragma unroll
        for (int g = 0; g < 8; ++g) { const int ai = g >> 2, m = g & 3; const size_t off = (size_t)(row0 + ai * HALF + m * 16) * ldc + col0;
            float sq = 0.f;
#pragma unroll
            for (int bj = 0; bj < 2; ++bj)
                { f32x4 b0, b1;
                  if constexpr (BASEF32) { b0 = *(const f32x4*)((const float*)base + off + bj * HALF); b1 = *(const f32x4*)((const float*)base + off + bj * HALF + 4); }
                  else { const u32x4 rw = *(const u32x4*)((const bf16_t*)base + off + bj * HALF);
                      b0.x = __builtin_bit_cast(float, rw.x << 16); b0.y = __builtin_bit_cast(float, rw.x & 0xffff0000u); b0.z = __builtin_bit_cast(float, rw.y << 16); b0.w = __builtin_bit_cast(float, rw.y & 0xffff0000u);
                      b1.x = __builtin_bit_cast(float, rw.z << 16); b1.y = __builtin_bit_cast(float, rw.z & 0xffff0000u); b1.z = __builtin_bit_cast(float, rw.w << 16); b1.w = __builtin_bit_cast(float, rw.w & 0xffff0000u); }
                  const f32x4 x0 = b0 + acc[ai][bj][m][0] * gv[bj][0], x1 = b1 + acc[ai][bj][m][1] * gv[bj][1]; acc[ai][bj][m][0] = x0; acc[ai][bj][m][1] = x1;
                  sq += ((x0.x * x0.x + x0.y * x0.y) + (x0.z * x0.z + x0.w * x0.w)) + ((x1.x * x1.x + x1.y * x1.y) + (x1.z * x1.z + x1.w * x1.w)); }
            sq += swz16_f(sq);
            { auto rr = __builtin_amdgcn_permlane32_swap(__builtin_bit_cast(unsigned, sq), __builtin_bit_cast(unsigned, sq), false, false); const unsigned r0_ = rr[0], r1_ = rr[1]; sq = __builtin_bit_cast(float, r0_) + __builtin_bit_cast(float, r1_); }
            p[g] = sq;
            if (g & 1) asm volatile("" ::: "memory"); }
        LAS float* red = (LAS float*)lds;
        if (fq == 0) {
#pragma unroll
            for (int g = 0; g < 8; ++g) red[wc * 256 + (g >> 2) * HALF + rowl0 + (g & 3) * 16] = p[g]; }
        __syncthreads();
        float* srow = ssq + ((size_t)u.pm * 256 + (tid & 255)) * 8;
        if (tid < 256) __hip_atomic_store(srow + u.pn, (red[tid] + red[256 + tid]) + (red[512 + tid] + red[768 + tid]), __ATOMIC_RELAXED, __HIP_MEMORY_SCOPE_AGENT);
        asm volatile("s_waitcnt vmcnt(0)" ::: "memory");
        __syncthreads();
        if (tid == 0) (void)__hip_atomic_fetch_add(pcnt + u.pm, 1u, __ATOMIC_RELAXED, __HIP_MEMORY_SCOPE_AGENT);
        if constexpr (!FINAL) {
#pragma unroll
            for (int g = 0; g < 8; ++g) { const int ai = g >> 2, m = g & 3; const size_t off = (size_t)(row0 + ai * HALF + m * 16) * ldc + col0;
#pragma unroll
                for (int bj = 0; bj < 2; ++bj) { const f32x4 x0 = acc[ai][bj][m][0], x1 = acc[ai][bj][m][1];
                    u32x4 w; w.x = pk2(x0.x, x0.y); w.y = pk2(x0.z, x0.w); w.z = pk2(x1.x, x1.y); w.w = pk2(x1.z, x1.w); *(u32x4*)((bf16_t*)out + off + bj * HALF) = w; } } }
#pragma unroll
        for (int bj = 0; bj < 2; ++bj)
#pragma unroll
            for (int n = 0; n < 2; ++n) { const int cc = col0 + bj * HALF + n * 4; nwv[bj][n] = *(const f32x4*)(nw + cc);
                if constexpr (!FINAL) { sc1[bj][n] = *(const f32x4*)(scale + (size_t)b * NMODC + cc) + 1.0f; sh[bj][n] = *(const f32x4*)(shift + (size_t)b * NMODC + cc); } }
        if (tid == 0) { unsigned sp = 0;
            while (__hip_atomic_load(pcnt + u.pm, __ATOMIC_RELAXED, __HIP_MEMORY_SCOPE_AGENT) < 8u) { __builtin_amdgcn_s_sleep(1);
                if ((++sp & 255u) == 0u) { if (__hip_atomic_load(tmo, __ATOMIC_RELAXED, __HIP_MEMORY_SCOPE_AGENT)) break; if (sp > (1u << 21)) { atomicAdd(tmo, 1u); break; } } } }
        __syncthreads();
        if (tid < 256) { float t8[8];
#pragma unroll
            for (int j = 0; j < 8; ++j) t8[j] = __hip_atomic_load(srow + j, __ATOMIC_RELAXED, __HIP_MEMORY_SCOPE_AGENT);
            red[1024 + tid] = 1.0f / sqrtf((((t8[0] + t8[1]) + (t8[2] + t8[3])) + ((t8[4] + t8[5]) + (t8[6] + t8[7]))) * (1.f / D) + NORM_EPS); }
        __syncthreads();
#pragma unroll
        for (int g = 0; g < 8; ++g) { const int ai = g >> 2, m = g & 3; const float rstd = red[1024 + ai * HALF + rowl0 + m * 16];
#pragma unroll
            for (int bj = 0; bj < 2; ++bj)
                if constexpr (FINAL) { float* op = (float*)out + (size_t)(row0 + ai * HALF + m * 16) * ldc + col0 + bj * HALF; *(f32x4*)op = acc[ai][bj][m][0] * rstd * nwv[bj][0]; *(f32x4*)(op + 4) = acc[ai][bj][m][1] * rstd * nwv[bj][1]; }
                else { bf16_t* rowp = Hn + (size_t)(row0 + ai * HALF + m * 16) * ldc + col0;
                    f32x4 y0 = acc[ai][bj][m][0] * rstd * nwv[bj][0]; y0 = y0 * sc1[bj][0] + sh[bj][0]; f32x4 y1 = acc[ai][bj][m][1] * rstd * nwv[bj][1]; y1 = y1 * sc1[bj][1] + sh[bj][1];
                    u32x4 w; w.x = pk2(y0.x, y0.y); w.y = pk2(y0.z, y0.w); w.z = pk2(y1.x, y1.y); w.w = pk2(y1.z, y1.w); *(u32x4*)(rowp + bj * HALF) = w; } }
        __syncthreads();
    }
};

}
__device__ __forceinline__ void norm_mod_phase(Frame& F, const float* x, const float* g, const float* shift, const float* scale, bf16* h) {
    const int gw = F.vcu * NWAVES + F.wave, NGW = F.G * NWAVES;
    int lane = F.lane; asm volatile("" : "+v"(lane));
#pragma unroll 1
    for (int m = gw; m < M; m += NGW) {
        const int b = m >> 11;
        const GAS f32x4* xr = (const GAS f32x4*)(x + (size_t)m * D) + lane;
        const GAS f32x4* gp = (const GAS f32x4*)g + lane; const GAS f32x4* shp = (const GAS f32x4*)(shift + (size_t)b * NMODC) + lane; const GAS f32x4* scp = (const GAS f32x4*)(scale + (size_t)b * NMODC) + lane;
        f32x4 v[8], gv[8], sh[8], sc[8]; float s = 0.f;
#pragma unroll
        for (int j = 0; j < 8; ++j) v[j] = xr[64 * j];
#pragma unroll
        for (int j = 0; j < 8; ++j) { gv[j] = gp[64 * j]; sh[j] = shp[64 * j]; sc[j] = scp[64 * j]; }
#pragma unroll
        for (int j = 0; j < 8; ++j) s += (v[j].x * v[j].x + v[j].y * v[j].y) + (v[j].z * v[j].z + v[j].w * v[j].w);
        const float rstd = 1.0f / sqrtf(wave_sum(s) * (1.f / D) + NORM_EPS);
        GAS v2u* o8 = (GAS v2u*)(h + (size_t)m * D) + lane;
#pragma unroll
        for (int j = 0; j < 8; ++j) {
            f32x4 y = v[j] * rstd * gv[j]; y = y * (sc[j] + 1.0f) + sh[j];
            v2u w; w.x = pk2(y.x, y.y); w.y = pk2(y.z, y.w); o8[64 * j] = w;
        }
    }
}
__device__ __forceinline__ void final_norm_phase(Frame& F, const float* x, const float* g, float* out) {
    const int gw = F.vcu * NWAVES + F.wave, NGW = F.G * NWAVES;
    for (int m = gw; m < M; m += NGW) {
        const GAS f32x4* xr = (const GAS f32x4*)(x + (size_t)m * D) + F.lane;
        f32x4 v[8]; float s = 0.f;
#pragma unroll
        for (int j = 0; j < 8; ++j) { v[j] = xr[64 * j]; s += (v[j].x * v[j].x + v[j].y * v[j].y) + (v[j].z * v[j].z + v[j].w * v[j].w); }
        const float rstd = 1.0f / sqrtf(wave_sum(s) * (1.f / D) + NORM_EPS);
        GAS f32x4* o = (GAS f32x4*)(out + (size_t)m * D) + F.lane;
#pragma unroll
        for (int j = 0; j < 8; ++j) { const f32x4 gv = *(const f32x4*)(g + 4 * F.lane + 256 * j); o[64 * j] = v[j] * rstd * gv; }
    }
}

struct MixW {
    const float *mu, *w0, *w2, *a0, *a2, *g2, *k_k, *k_a, *r_k, *ln_w, *ln_b, *v0, *v1, *v2, *conv_w, *conv_b, *dt_bias, *a_log, *d_skip, *norm_w;
    int layer;
};
constexpr float ATT_C2 = 0.125f * 1.4426950408889634f;
__device__ __forceinline__ void attn_prep_tok(Frame& F, int m, const float* u, const float* rc, const float* rs, bf16* Q, bf16* Kb, bf16* Vb, bf16* IQ, bf16* IK, float* IW) {
    const float* ur = u + (size_t)m * DINP; const float* c = rc + (size_t)m * 32; const float* s = rs + (size_t)m * 32;
    int tid0 = F.tid; asm volatile("" : "+v"(tid0));
    for (int i = tid0; i < 33 * 32; i += NTHR) {
        const int hh = i >> 5, j = i & 31;
        const float* src; bf16* dst; float sc = 1.f;
        if (hh < 8) { src = ur + U_Q + hh * 64; dst = Q + (size_t)m * AW + hh * 64; sc = ATT_C2; }
        else if (hh < 16) { src = ur + U_K + (hh - 8) * 64; dst = Kb + (size_t)m * AW + (hh - 8) * 64; }
        else if (hh < 32) { src = ur + U_IQ + (hh - 16) * 64; dst = IQ + (size_t)m * 1024 + (hh - 16) * 64; }
        else { src = ur + U_IK; dst = IK + (size_t)m * 64; }
        const float x1 = src[j], x2 = src[j + 32];
        dst[j] = (bf16)f2bf((x1 * c[j] - x2 * s[j]) * sc); dst[j + 32] = (bf16)f2bf((x2 * c[j] + x1 * s[j]) * sc);
    }
    { const int i = tid0; Vb[(size_t)m * AW + i] = (bf16)f2bf(ur[U_V + i]); }
    if (tid0 < 16) IW[(size_t)m * 16 + tid0] = ur[U_IW + tid0] * (0.25f * 0.125f);
}
__device__ __forceinline__ void rwkv_prep_tok(Frame& F, int m, const float* u, const MixW& w, float* vfirst, float* R, float* Wd, float* K, float* V, float* A, float* Bv, float* G) {
    const int t = m & (T - 1); int tid = F.tid; asm volatile("" : "+v"(tid));
    LAS float* xs = (LAS float*)F.lds;
    LAS float* t32 = xs + RC;
    LAS float* av = t32 + 32;
    LAS float* kkv = av + RW;
    LAS float* hn = kkv + RW;
    LAS float* act = hn + 16;
    const float* ur = u + (size_t)m * DINP + U_RW;
    for (int c = tid; c < RC; c += NTHR) { const float cur = ur[c]; const float prev = (t > 0) ? ur[c - DINP] : 0.f; xs[c] = cur + (prev - cur) * w.mu[c]; }
    __syncthreads();
    LAS float* xr = xs; LAS float* xk = xs + 768; LAS float* xv = xs + 1536; LAS float* wl = xs + 2304; LAS float* al = xs + 2368; LAS float* gl = xs + 2432;
    if (tid < 64) act[tid] = tanhf(wl[tid]); else if (tid < 128) act[tid] = al[tid - 64]; else if (tid < 256) act[tid] = sigmoidf_(gl[tid - 128]);
    LAS float* t32p = act + 256;
    if (w.layer > 0) { const int q = tid & 31, part = tid >> 5; float s = 0.f; for (int c = part * 48; c < part * 48 + 48; ++c) s += xv[c] * w.v1[c * 32 + q]; t32p[part * 32 + q] = s; }
    __syncthreads();
    if (w.layer > 0 && tid < 32) { float s = 0.f;
#pragma unroll
        for (int pp = 0; pp < 16; ++pp) s += t32p[pp * 32 + tid]; t32[tid] = s; }
    __syncthreads();
    for (int c = tid; c < RW; c += NTHR) {
        float sw = w.w0[c], sa = w.a0[c], sg = 0.f;
        for (int j = 0; j < 64; ++j) { sw += act[j] * w.w2[j * RW + c]; sa += act[64 + j] * w.a2[j * RW + c]; }
        for (int j = 0; j < 128; ++j) sg += act[128 + j] * w.g2[j * RW + c];
        const float w_log = -softplusf_(-sw) - 0.5f;
        const float decay = expf(-expf(w_log));
        const float a = sigmoidf_(sa);
        float v = xv[c];
        if (w.layer == 0) vfirst[(size_t)m * RW + c] = v;
        else { float s = w.v0[c]; for (int j = 0; j < 32; ++j) s += t32[j] * w.v2[j * RW + c]; v = v + (vfirst[(size_t)m * RW + c] - v) * sigmoidf_(s); }
        av[c] = a; kkv[c] = xk[c] * w.k_k[c];
        R[(size_t)m * RW + c] = xr[c]; Wd[(size_t)m * RW + c] = decay; V[(size_t)m * RW + c] = v; G[(size_t)m * RW + c] = sg;
        K[(size_t)m * RW + c] = xk[c] * (1.f + (a - 1.f) * w.k_a[c]);
    }
    __syncthreads();
    { const int lane_ = tid & 63, wv_ = F.wave;
      for (int hh = wv_; hh < RH; hh += NWAVES) { const float q = kkv[hh * 64 + lane_]; const float ss = wave_sum(q * q); if (lane_ == 0) hn[hh] = fmaxf(sqrtf(ss), 1e-12f); } }
    __syncthreads();
    for (int c = tid; c < RW; c += NTHR) { const float kk = kkv[c] / hn[c >> 6]; A[(size_t)m * RW + c] = -kk; Bv[(size_t)m * RW + c] = kk * av[c]; }
    __syncthreads();
}
__device__ __forceinline__ void ssm_prep_tok(Frame& F, int m, const float* u, const MixW& w, float* XBC, float* DT, bf16* sB, bf16* sC) {
    const int t = m & (T - 1); int tid = F.tid; asm volatile("" : "+v"(tid));
    for (int c = tid; c < SCD; c += NTHR) {
        float y = w.conv_b[c];
#pragma unroll
        for (int j = 0; j < 4; ++j) { const int tt = t - 3 + j; if (tt >= 0) y += w.conv_w[c * 4 + j] * u[(size_t)(m - 3 + j) * DINP + U_XBC + c]; }
        const float sv = siluf_(y);
        XBC[(size_t)m * SCD + c] = sv;
        if (c >= 1280) sC[(size_t)m * 512 + (c - 1280)] = (bf16)f2bf(sv); else if (c >= 768) sB[(size_t)m * 512 + (c - 768)] = (bf16)f2bf(sv);
    }
    if (tid < SH) DT[(size_t)m * SH + tid] = softplusf_(u[(size_t)m * DINP + U_DT + tid] + w.dt_bias[tid]);
}
typedef short bf16x8v __attribute__((ext_vector_type(8)));
typedef float f32x16 __attribute__((ext_vector_type(16)));
__device__ __forceinline__ int half32_sum_i(int x) { x += dpp_i<0xB1>(x); x += dpp_i<0x4E>(x); x += dpp_i<0x141>(x); x += dpp_i<0x140>(x); x += swz16_i(x); return x; }
__device__ __forceinline__ float half32_min_f(float x) { x = fminf(x, dpp_f<0xB1>(x)); x = fminf(x, dpp_f<0x4E>(x)); x = fminf(x, dpp_f<0x141>(x)); x = fminf(x, dpp_f<0x140>(x)); x = fminf(x, swz16_f(x)); return x; }
__device__ __forceinline__ float half32_max_f(float x) { x = fmaxf(x, dpp_f<0xB1>(x)); x = fmaxf(x, dpp_f<0x4E>(x)); x = fmaxf(x, dpp_f<0x141>(x)); x = fmaxf(x, dpp_f<0x140>(x)); x = fmaxf(x, swz16_f(x)); return x; }
template <int LN> __device__ __forceinline__ void wlane(unsigned& x, unsigned v) { asm volatile("s_nop 1\n\tv_writelane_b32 %0, %1, %2" : "+v"(x) : "s"(v), "n"(LN)); }
template <int I> struct MaskBuild {
    static __device__ __forceinline__ void run(const float (&sc)[64], float thr, unsigned& X, unsigned& Y, unsigned& Z, unsigned& Wd) {
        const unsigned long long bal = __builtin_amdgcn_ballot_w64(sc[I] >= thr);
        const unsigned blo = (unsigned)bal, bhi = (unsigned)(bal >> 32);
        if ((I & 1) == 0) { wlane<(I >> 1)>(X, blo); wlane<(I >> 1)>(Z, bhi); } else { wlane<(I >> 1)>(Y, blo); wlane<(I >> 1)>(Wd, bhi); }
        MaskBuild<I + 1>::run(sc, thr, X, Y, Z, Wd);
    }
};
template <> struct MaskBuild<64> { static __device__ __forceinline__ void run(const float (&)[64], float, unsigned&, unsigned&, unsigned&, unsigned&) {} };
constexpr int IKC_BYTES = 256 * 144;
__device__ __forceinline__ void idx_unit(Frame& F, int unit, const bf16* IQ, const bf16* IK, const float* IW, unsigned long long* MK) {
    int tid = F.tid; asm volatile("" : "+v"(tid));
    const int lane = tid & 63, wave = F.wave, c32 = lane & 31, hi = lane >> 5;
    const int b = unit & 3, g = 127 - (unit >> 2), t0 = g * 16;
    const int qa = t0 + 2 * wave, tq = qa + hi;
    const int nchunk = (t0 + 16 + 255) >> 8;
    LAS unsigned char* lds = F.lds;
    bf16x8v Af[4];
    { const int qsel = (c32 >> 2) & 1, head = (c32 & 3) + 4 * (c32 >> 3);
      const bf16* aptr = IQ + (size_t)(b * T + qa + qsel) * 1024 + head * 64 + 8 * hi;
#pragma unroll
      for (int ks = 0; ks < 4; ++ks) Af[ks] = *(const GAS bf16x8v*)(aptr + 16 * ks); }
    LAS float* wl = (LAS float*)(lds + 2 * IKC_BYTES) + (wave * 2 + hi) * 16;
    if (c32 < 16) wl[c32] = IW[(size_t)(b * T + tq) * 16 + c32];
    float sc[64];
#pragma unroll
    for (int i = 0; i < 64; ++i) sc[i] = -INFINITY;
    const bf16* ikb = IK + (size_t)b * T * 64;
    v4u stg[4];
    const int st_key = tid >> 1, st_half = tid & 1;
#define IDX_ISSUE(ch) do { const GAS v4u* src_ = (const GAS v4u*)(ikb + (size_t)((ch) * 256 + st_key) * 64 + st_half * 32); _Pragma("unroll") for (int j_ = 0; j_ < 4; ++j_) stg[j_] = src_[j_]; } while (0)
#define IDX_STORE(buf) do { LAS v4u* dst_ = (LAS v4u*)(lds + (buf) * IKC_BYTES + st_key * 144 + st_half * 64); _Pragma("unroll") for (int j_ = 0; j_ < 4; ++j_) dst_[j_] = stg[j_]; } while (0)
    IDX_ISSUE(0); IDX_STORE(0);
    __syncthreads();
#pragma unroll
    for (int ch = 0; ch < 8; ++ch) {
        if (ch < nchunk) {
            if (ch + 1 < nchunk) IDX_ISSUE(ch + 1);
            const LAS unsigned char* bb = lds + (ch & 1) * IKC_BYTES + c32 * 144 + hi * 16;
#pragma unroll
            for (int tl = 0; tl < 8; ++tl) {
                f32x16 acc = {};
#pragma unroll
                for (int ks = 0; ks < 4; ++ks) { const bf16x8v Bf = *(const LAS bf16x8v*)(bb + tl * 32 * 144 + ks * 32); acc = __builtin_amdgcn_mfma_f32_32x32x16_bf16(Af[ks], Bf, acc, 0, 0, 0); }
                float sv = 0.f;
#pragma unroll
                for (int r4 = 0; r4 < 4; ++r4) { const f32x4 wv = *(const LAS f32x4*)(wl + 4 * r4);
#pragma unroll
                    for (int r = 0; r < 4; ++r) sv = fmaf(wv[r], fmaxf(acc[4 * r4 + r], 0.f), sv); }
                const int key = (ch * 8 + tl) * 32 + c32;
                sv = (key > tq) ? -INFINITY : sv;
                asm volatile("" : "+v"(sv));
                sc[ch * 8 + tl] = sv;
            }
            if (ch + 1 < nchunk) IDX_STORE((ch + 1) & 1);
            __syncthreads();
        }
    }
#undef IDX_ISSUE
#undef IDX_STORE
    float thr = -3.0e38f;
    {
        const bool need = (tq + 1) > TOPK;
        float mn = INFINITY, mx = -INFINITY;
#pragma unroll
        for (int i = 0; i < 64; ++i) { const float v = sc[i]; mx = fmaxf(mx, v); mn = fminf(mn, (v == -INFINITY) ? INFINITY : v); }
        mn = half32_min_f(mn); mx = half32_max_f(mx);
        float lo = mn, hb = mx; bool done = !need;
#pragma unroll 1
        for (int it = 0; it < 64; ++it) {
            if (__builtin_amdgcn_ballot_w64(!done) == 0ull) break;
            const float mid = 0.5f * (lo + hb);
            int cnt = 0;
#pragma unroll
            for (int i = 0; i < 64; ++i) cnt += (sc[i] >= mid) ? 1 : 0;
            cnt = half32_sum_i(cnt);
            if (!done) {
                if (cnt == TOPK) { thr = mid; done = true; }
                else if (!(mid > lo && mid < hb)) { thr = lo; done = true; }
                else if (cnt > TOPK) lo = mid; else hb = mid;
            }
        }
        if (!done) thr = lo;
    }
    unsigned X = 0u, Y = 0u, Z = 0u, Wd = 0u;
    MaskBuild<0>::run(sc, thr, X, Y, Z, Wd);
    if (lane < 32) { v4u o; o.x = X; o.y = Y; o.z = Z; o.w = Wd; *(v4u*)(MK + ((size_t)(b * 32 + lane) * T + qa)) = o; }
    __syncthreads();
}
typedef float f32x2_t_ __attribute__((ext_vector_type(2))); typedef __bf16 bf16x2_t_ __attribute__((ext_vector_type(2)));
__device__ __forceinline__ unsigned cvtpk(float lo, float hi) { f32x2_t_ v = {lo, hi}; bf16x2_t_ b = __builtin_convertvector(v, bf16x2_t_); return __builtin_bit_cast(unsigned, b); }
typedef short v4i16_t __attribute__((ext_vector_type(4)));
__device__ __forceinline__ bf16x8v ldsB128(const LAS unsigned char* p) { return *(const LAS bf16x8v*)p; }
constexpr int SD_BP = 272, SD_XP = 528;
constexpr int SD_BS = 0, SD_XT = 256 * SD_BP, SD_CS = SD_XT + 64 * SD_XP, SD_DEC = SD_CS + 1024, SD_END = SD_DEC + 1024;
static_assert(SD_END <= RING_BYTES, "ssd lds");
__device__ __forceinline__ void ssd_pass1_unit(Frame& F, int unit, const bf16* XBC, const float* DT, const bf16* sB, const bf16* sC, const float* a_log, float* YD, float* ST, float* CS, float* TOT) {
    int tid = F.tid; asm volatile("" : "+v"(tid));
    const int lane = tid & 63, wave = F.wave, r32 = lane & 31, hi = lane >> 5;
    const int b = unit >> 5, g = (unit >> 3) & 3, c = unit & 7;
    const size_t row0 = (size_t)b * T + (size_t)c * 256;
    LAS unsigned char* lds = F.lds;
    { const int r = tid >> 1, hf = tid & 1; const GAS v4u* src = (const GAS v4u*)(sB + (row0 + r) * 512 + g * 128 + hf * 64); LAS v4u* dst = (LAS v4u*)(lds + SD_BS + r * SD_BP + hf * 128);
#pragma unroll
      for (int j = 0; j < 8; ++j) dst[j] = src[j]; }
#pragma unroll 1
    for (int hh = 0; hh < 3; ++hh) {
        const int h = 3 * g + hh;
        const float Ah = -expf(a_log[h]);
        LAS float* csb = (LAS float*)(lds + SD_CS); LAS float* decb = (LAS float*)(lds + SD_DEC);
        if (wave == 0) {
            float a4[4];
#pragma unroll
            for (int i = 0; i < 4; ++i) a4[i] = Ah * DT[(row0 + 4 * lane + i) * SH + h];
            a4[1] += a4[0]; a4[2] += a4[1]; a4[3] += a4[2];
            float x = a4[3];
            x += dpp_f<0x111>(x); x += dpp_f<0x112>(x); x += dpp_f<0x114>(x); x += dpp_f<0x118>(x);
            const float r0 = rdlane_f(x, 15), r1 = rdlane_f(x, 31), r2 = rdlane_f(x, 47);
            const int rw = lane >> 4; x += (rw >= 1 ? r0 : 0.f) + (rw >= 2 ? r1 : 0.f) + (rw >= 3 ? r2 : 0.f);
            const float tot = rdlane_f(x, 63);
            const float excl = x - a4[3];
#pragma unroll
            for (int i = 0; i < 4; ++i) { const float cv = excl + a4[i]; csb[4 * lane + i] = cv; decb[4 * lane + i] = fexp_(tot - cv); CS[(row0 + 4 * lane + i) * SH + h] = cv; }
            if (lane == 0) TOT[(b * SH + h) * 8 + c] = tot;
        }
        { const int l = tid >> 1, ph = tid & 1; const float dtl = DT[(row0 + l) * SH + h];
          const bf16* src = XBC + (row0 + l) * 768 + h * 64 + 32 * ph;
          const int s16 = l & 15, pos = (l & ~15) + 8 * ((s16 >> 2) & 1) + 4 * (s16 >> 3) + (s16 & 3);
          LAS bf16* xt = (LAS bf16*)(lds + SD_XT) + pos;
#pragma unroll
          for (int j = 0; j < 8; ++j) { const f32x4 v = ld4bf(src + 4 * j);
#pragma unroll
              for (int i = 0; i < 4; ++i) xt[(32 * ph + 4 * j + i) * (SD_XP / 2)] = (bf16)f2bf(v[i] * dtl); } }
        __syncthreads();
#pragma unroll 1
        for (int li = 0; li < 2; ++li) {
            const int ltile = li == 0 ? wave : 7 - wave;
            bf16x8v Cf[8];
            { const bf16* cp = sC + (row0 + 32 * ltile + r32) * 512 + g * 128 + 8 * hi;
#pragma unroll
              for (int ks = 0; ks < 8; ++ks) Cf[ks] = *(const GAS bf16x8v*)(cp + 16 * ks); }
            const float csl = csb[32 * ltile + r32];
            f32x16 YT0 = {}, YT1 = {};
#pragma unroll 1
            for (int stile = 0; stile <= ltile; ++stile) {
                f32x16 GT = {};
                const LAS unsigned char* bp = lds + SD_BS + (32 * stile + r32) * SD_BP + hi * 16;
#pragma unroll
                for (int ks = 0; ks < 8; ++ks) GT = __builtin_amdgcn_mfma_f32_32x32x16_bf16(ldsB128(bp + ks * 32), Cf[ks], GT, 0, 0, 0);
                const bool diag = (stile == ltile);
                unsigned pk[8];
#pragma unroll
                for (int q = 0; q < 4; ++q) { const f32x4 css = *(const LAS f32x4*)(csb + 32 * stile + 8 * q + 4 * hi);
                    float v[4];
#pragma unroll
                    for (int i = 0; i < 4; ++i) { const float e = __builtin_amdgcn_exp2f((csl - css[i]) * 1.4426950408889634f); v[i] = GT[4 * q + i] * e; if (diag && (8 * q + 4 * hi + i) > r32) v[i] = 0.f; }
                    pk[2 * q] = cvtpk(v[0], v[1]); pk[2 * q + 1] = cvtpk(v[2], v[3]); }
                bf16x8v G0, G1; { v4u t0 = {pk[0], pk[1], pk[2], pk[3]}, t1 = {pk[4], pk[5], pk[6], pk[7]}; G0 = __builtin_bit_cast(bf16x8v, t0); G1 = __builtin_bit_cast(bf16x8v, t1); }
                const LAS unsigned char* xp = lds + SD_XT + r32 * SD_XP + (32 * stile + 8 * hi) * 2;
                YT0 = __builtin_amdgcn_mfma_f32_32x32x16_bf16(ldsB128(xp), G0, YT0, 0, 0, 0);
                YT0 = __builtin_amdgcn_mfma_f32_32x32x16_bf16(ldsB128(xp + 32), G1, YT0, 0, 0, 0);
                YT1 = __builtin_amdgcn_mfma_f32_32x32x16_bf16(ldsB128(xp + 32 * SD_XP), G0, YT1, 0, 0, 0);
                YT1 = __builtin_amdgcn_mfma_f32_32x32x16_bf16(ldsB128(xp + 32 * SD_XP + 32), G1, YT1, 0, 0, 0);
            }
            float* yo = YD + (row0 + 32 * ltile + r32) * SW + h * 64 + 4 * hi;
#pragma unroll
            for (int q = 0; q < 4; ++q) { f32x4 o0 = {YT0[4 * q], YT0[4 * q + 1], YT0[4 * q + 2], YT0[4 * q + 3]}, o1 = {YT1[4 * q], YT1[4 * q + 1], YT1[4 * q + 2], YT1[4 * q + 3]};
                *(f32x4*)(yo + 8 * q) = o0; *(f32x4*)(yo + 32 + 8 * q) = o1; }
        }
        {
            const int pt = wave & 1, nt = wave >> 1;
            f32x16 acc = {};
            const LAS unsigned char* xp = lds + SD_XT + (32 * pt + r32) * SD_XP + 8 * hi * 2;
            const LAS unsigned char* bt = lds + SD_BS + (4 * hi + ((lane & 15) >> 2)) * SD_BP + (32 * nt + 16 * ((lane >> 4) & 1) + 4 * (lane & 3)) * 2;
#pragma unroll 4
            for (int kk = 0; kk < 16; ++kk) {
                const bf16x8v xa = ldsB128(xp + kk * 32);
                const f32x4 d0 = *(const LAS f32x4*)(decb + 16 * kk + 4 * hi), d1 = *(const LAS f32x4*)(decb + 16 * kk + 8 + 4 * hi);
                const v4u xu = __builtin_bit_cast(v4u, xa); unsigned po[4];
#pragma unroll
                for (int w2 = 0; w2 < 4; ++w2) { const float lo = __builtin_bit_cast(float, xu[w2] << 16), hv = __builtin_bit_cast(float, xu[w2] & 0xffff0000u);
                    const float dl = (w2 < 2) ? d0[2 * w2] : d1[2 * (w2 - 2)], dh = (w2 < 2) ? d0[2 * w2 + 1] : d1[2 * (w2 - 2) + 1];
                    po[w2] = cvtpk(lo * dl, hv * dh); }
                const v4u pa = {po[0], po[1], po[2], po[3]};
                const v4i16_t blo = __builtin_amdgcn_ds_read_tr16_b64_v4i16((LAS v4i16_t*)(bt + kk * 16 * SD_BP));
                const v4i16_t bhi = __builtin_amdgcn_ds_read_tr16_b64_v4i16((LAS v4i16_t*)(bt + kk * 16 * SD_BP + 8 * SD_BP));
                const bf16x8v bfr = {blo[0], blo[1], blo[2], blo[3], bhi[0], bhi[1], bhi[2], bhi[3]};
                acc = __builtin_amdgcn_mfma_f32_32x32x16_bf16(__builtin_bit_cast(bf16x8v, pa), bfr, acc, 0, 0, 0);
            }
            float* so = ST + ((size_t)((b * SH + h) * 8 + c) * 64 + 32 * pt) * 128 + 32 * nt + r32;
#pragma unroll
            for (int r = 0; r < 16; ++r) so[(size_t)((r & 3) + 8 * (r >> 2) + 4 * hi) * 128] = acc[r];
        }
        __syncthreads();
    }
}
constexpr int S2_SP = 272;
__device__ __forceinline__ void ssd_pass2_unit(Frame& F, int unit, const bf16* XBC, const bf16* UUp, const bf16* sC, const float* YD, const float* ST, const float* CS, const float* TOT, const float* d_skip, const float* norm_w, bf16* cat) {
    int tid = F.tid; asm volatile("" : "+v"(tid));
    const int lane = tid & 63, wave = F.wave, r32 = lane & 31, hi = lane >> 5;
    const int b = unit >> 5, g = (unit >> 3) & 3, c = unit & 7;
    const size_t row0 = (size_t)b * T + (size_t)c * 256;
    LAS unsigned char* lds = F.lds;
#pragma unroll 1
    for (int hh = 0; hh < 3; ++hh) {
        const int h = 3 * g + hh; const int p = tid >> 3, n0 = (tid & 7) * 16;
        f32x4 S[4] = {};
        for (int cc = 0; cc < c; ++cc) { const float dk = fexp_(TOT[(b * SH + h) * 8 + cc]); const GAS f32x4* sp = (const GAS f32x4*)(ST + ((size_t)((b * SH + h) * 8 + cc) * 64 + p) * 128 + n0);
#pragma unroll
            for (int j = 0; j < 4; ++j) S[j] = S[j] * dk + sp[j]; }
        v4u o0 = {pg8::cvt_pk_bf16(S[0][0], S[0][1]), pg8::cvt_pk_bf16(S[0][2], S[0][3]), pg8::cvt_pk_bf16(S[1][0], S[1][1]), pg8::cvt_pk_bf16(S[1][2], S[1][3])};
        v4u o1 = {pg8::cvt_pk_bf16(S[2][0], S[2][1]), pg8::cvt_pk_bf16(S[2][2], S[2][3]), pg8::cvt_pk_bf16(S[3][0], S[3][1]), pg8::cvt_pk_bf16(S[3][2], S[3][3])};
        LAS v4u* dst = (LAS v4u*)(lds + (hh * 64 + p) * S2_SP + n0 * 2); dst[0] = o0; dst[1] = o1;
    }
    __syncthreads();
    const size_t l = row0 + 32 * wave + r32;
    bf16x8v Cf[8];
    { const bf16* cp = sC + l * 512 + g * 128 + 8 * hi;
#pragma unroll
      for (int ks = 0; ks < 8; ++ks) Cf[ks] = *(const GAS bf16x8v*)(cp + 16 * ks); }
    f32x16 acc[3][2];
#pragma unroll
    for (int hh = 0; hh < 3; ++hh)
#pragma unroll
        for (int pt = 0; pt < 2; ++pt) { f32x16 a = {};
            const LAS unsigned char* sp = lds + (hh * 64 + 32 * pt + r32) * S2_SP + hi * 16;
#pragma unroll
            for (int ks = 0; ks < 8; ++ks) a = __builtin_amdgcn_mfma_f32_32x32x16_bf16(ldsB128(sp + ks * 32), Cf[ks], a, 0, 0, 0);
            acc[hh][pt] = a; }
    float ss = 0.f;
#pragma unroll
    for (int hh = 0; hh < 3; ++hh) { const int h = 3 * g + hh; const float ecs = fexp_(CS[l * SH + h]), Dh = d_skip[h];
#pragma unroll
        for (int pt = 0; pt < 2; ++pt)
#pragma unroll
            for (int q = 0; q < 4; ++q) { const int col = h * 64 + 32 * pt + 8 * q + 4 * hi;
                const f32x4 yd = *(const GAS f32x4*)(YD + l * SW + col), xs = ld4bf(XBC + l * 768 + col), z4 = ld4bf(UUp + l * DINP + U_Z + col);
#pragma unroll
                for (int i = 0; i < 4; ++i) { const float y = yd[i] + ecs * acc[hh][pt][4 * q + i] + Dh * xs[i]; const float gv = y * siluf_(z4[i]); acc[hh][pt][4 * q + i] = gv; ss += gv * gv; } } }
    { auto rr = __builtin_amdgcn_permlane32_swap(__builtin_bit_cast(unsigned, ss), __builtin_bit_cast(unsigned, ss), false, false); const unsigned r0_ = rr[0], r1_ = rr[1]; ss = __builtin_bit_cast(float, r0_) + __builtin_bit_cast(float, r1_); }
    const float rms = __builtin_amdgcn_rsqf(ss * (1.f / 192.f) + 1e-5f);
#pragma unroll
    for (int hh = 0; hh < 3; ++hh) { const int h = 3 * g + hh;
#pragma unroll
        for (int pt = 0; pt < 2; ++pt)
#pragma unroll
            for (int q = 0; q < 4; ++q) { const int col = h * 64 + 32 * pt + 8 * q + 4 * hi; const f32x4 nw = *(const GAS f32x4*)(norm_w + col);
                v2u o; o.x = pg8::cvt_pk_bf16(acc[hh][pt][4 * q] * rms * nw[0], acc[hh][pt][4 * q + 1] * rms * nw[1]); o.y = pg8::cvt_pk_bf16(acc[hh][pt][4 * q + 2] * rms * nw[2], acc[hh][pt][4 * q + 3] * rms * nw[3]);
                *(GAS v2u*)(cat + l * D + AW + RW + col) = o; } }
    __syncthreads();
}

constexpr int PV_AP = 528, PV_VP = 1552;
constexpr int PV_ACT = 0, PV_V = 32 * PV_AP, PV_P32 = PV_V + 32 * PV_VP;
constexpr int PV_CH = PV_V, PV_CHB = 32 * 256 * 4;
constexpr int PV_V32 = PV_CH + 3 * PV_CHB, PV_END = PV_V32 + 32 * 80;
static_assert(PV_P32 + 8 * 4096 <= PV_V32 && PV_END <= RING_BYTES, "prep lds");
static_assert(PV_END <= RING_BYTES, "prep lds");
struct PrepBufs { float *R, *Wd, *K, *V, *A, *Bv, *VF, *DT; bf16 *G, *XBC, *sB, *sC, *Q, *Kb, *Vb, *IQ, *IK; float* IW; const float *rc, *rs; const bf16* lw; };
__device__ __forceinline__ void prep_unit(Frame& F, int unit, const bf16* u, const MixW& w, const PrepBufs& P) {
    int tid = F.tid; asm volatile("" : "+v"(tid));
    const int lane = tid & 63, wave = F.wave, r32 = lane & 31, hi = lane >> 5;
    const size_t m0 = (size_t)unit * 32; const int t0 = (int)(m0 & (T - 1));
    LAS unsigned char* lds = F.lds;
    {
        const int tl = tid >> 4, l16 = tid & 15; const size_t m = m0 + tl; const bool hasprev = (t0 + tl) > 0;
        const bf16* ur = u + m * DINP + U_RW;
        const f32x4 zero4 = {0.f, 0.f, 0.f, 0.f};
        const v2u zero2 = {0u, 0u}; (void)zero4;
        v2u rc_[2][4], rp_[2][4]; f32x4 rm_[2][4];
#define PREP_ISSUE(S, IT0) { _Pragma("unroll") for (int q_ = 0; q_ < 4; ++q_) { const int c_ = 64 * ((IT0) + q_) + 4 * l16; rc_[S][q_] = *(const GAS v2u*)(ur + c_); \
            rp_[S][q_] = hasprev ? *(const GAS v2u*)(ur - DINP + c_) : zero2; rm_[S][q_] = *(const GAS f32x4*)(w.mu + c_); } }
#define PREP_FIN(S) f32x4 xs_[4]; { _Pragma("unroll") for (int q_ = 0; q_ < 4; ++q_) { const f32x4 cur_ = cvt4bf(rc_[S][q_]), prv_ = cvt4bf(rp_[S][q_]); xs_[q_] = cur_ + (prv_ - cur_) * rm_[S][q_]; } }
#define R_BODY(I4) { _Pragma("unroll") for (int q = 0; q < 4; ++q) *(LAS f32x4*)(lds + PV_CH + (tl * 256 + 64 * q + 4 * l16) * 4) = xs_[q]; }
#define K_BODY(I4) { _Pragma("unroll") for (int q = 0; q < 4; ++q) { const f32x4 kq = xs_[q] * kk4[q]; \
            const float ss = row16_sum((kq[0] * kq[0] + kq[1] * kq[1]) + (kq[2] * kq[2] + kq[3] * kq[3])); const float inv = -__builtin_amdgcn_rsqf(fmaxf(ss, 1e-24f)); \
            *(LAS f32x4*)(lds + PV_CH + 2 * PV_CHB + (tl * 256 + 64 * q + 4 * l16) * 4) = kq * inv; *(LAS f32x4*)(lds + PV_CH + PV_CHB + (tl * 256 + 64 * q + 4 * l16) * 4) = xs_[q]; } }
#define KK_LOAD(I4) f32x4 kk4[4]; { _Pragma("unroll") for (int q = 0; q < 4; ++q) kk4[q] = *(const GAS f32x4*)(w.k_k + 64 * (4 * (I4) + q) + 4 * l16 - 768); }
#define PREP_STEP1_VARS() const int tl = tid >> 4, l16 = tid & 15; const size_t m = m0 + tl; const bool hasprev = (t0 + tl) > 0; const bf16* ur = u + m * DINP + U_RW; const v2u zero2 = {0u, 0u}; (void)m; v2u rc_[2][4], rp_[2][4]; f32x4 rm_[2][4];
#define V_BODY(I4) { _Pragma("unroll") for (int q = 0; q < 4; ++q) { const int cc = 64 * (4 * (I4) + q) + 4 * l16 - 1536; \
            if (w.layer == 0) *(GAS f32x4*)(P.VF + m * RW + cc) = xs_[q];        \
            else { *(GAS f32x4*)(P.V + m * RW + cc) = xs_[q]; v2u o; o.x = pg8::cvt_pk_bf16(xs_[q][0], xs_[q][1]); o.y = pg8::cvt_pk_bf16(xs_[q][2], xs_[q][3]); *(LAS v2u*)(lds + PV_V + tl * PV_VP + cc * 2) = o; } } }
        PREP_ISSUE(0, 24)
        { PREP_ISSUE(1, 28) PREP_FIN(0) V_BODY(6) }
        { PREP_ISSUE(0, 32) PREP_FIN(1) V_BODY(7) }
        { PREP_ISSUE(1, 36) PREP_FIN(0) V_BODY(8) }
        { PREP_FIN(1)
#pragma unroll
            for (int q = 0; q < 4; ++q) { const int cc = 64 * q + 4 * l16; f32x4 a4; const f32x4 xq = xs_[q];
                if (q == 0) { a4[0] = ftanh_(xq[0]); a4[1] = ftanh_(xq[1]); a4[2] = ftanh_(xq[2]); a4[3] = ftanh_(xq[3]); }
                else if (q == 1) a4 = xq;
                else { a4[0] = sigmoidf_(xq[0]); a4[1] = sigmoidf_(xq[1]); a4[2] = sigmoidf_(xq[2]); a4[3] = sigmoidf_(xq[3]); }
                v2u o; o.x = pg8::cvt_pk_vis(a4[0], a4[1]); o.y = pg8::cvt_pk_vis(a4[2], a4[3]); *(LAS v2u*)(lds + PV_ACT + tl * PV_AP + cc * 2) = o; } }
#undef V_BODY
    }
    __syncthreads();
    if (w.layer > 0) {
        f32x16 acc = {};
        const LAS unsigned char* ap = lds + PV_V + r32 * PV_VP + hi * 16; const bf16* bp = P.lw + LW_V1 + (size_t)r32 * 768 + 8 * hi;
#pragma unroll
        for (int k6 = 0; k6 < 6; ++k6) { const int ks = wave * 6 + k6; acc = __builtin_amdgcn_mfma_f32_32x32x16_bf16(ldsB128(ap + ks * 32), *(const GAS bf16x8v*)(bp + ks * 16), acc, 0, 0, 0); }
        LAS float* pp = (LAS float*)(lds + PV_P32 + wave * 4096);
#pragma unroll
        for (int r = 0; r < 16; ++r) pp[((r & 3) + 8 * (r >> 2) + 4 * hi) * 32 + r32] = acc[r];
        __syncthreads();
        { const int e0 = tid * 2; float s0 = 0.f, s1 = 0.f;
#pragma unroll
          for (int wv = 0; wv < 8; ++wv) { const LAS float* q = (const LAS float*)(lds + PV_P32 + wv * 4096) + e0; s0 += q[0]; s1 += q[1]; }
          *(LAS unsigned*)(lds + PV_V32 + (e0 >> 5) * 80 + (e0 & 31) * 2) = pg8::cvt_pk_bf16(s0, s1); }
        __syncthreads();
    }
#pragma unroll 1
    for (int j = 0; j < 3; ++j) {
        { PREP_STEP1_VARS()
          KK_LOAD(3 + j) PREP_ISSUE(0, 4 * j)
          { PREP_ISSUE(1, 12 + 4 * j) PREP_FIN(0) R_BODY(j) }
          { PREP_FIN(1) K_BODY(3 + j) } }
        __syncthreads();
        const int ct = 8 * j + wave, c = 32 * ct + r32;
        const LAS float* chl = (const LAS float*)(lds + PV_CH) + 32 * wave + r32;
        f32x16 accW = {}, accA = {}, accG = {}, accV = {};
        const LAS unsigned char* ap = lds + PV_ACT + r32 * PV_AP + hi * 16;
        const bf16* bw = P.lw + LW_W2 + (size_t)c * 64 + 8 * hi; const bf16* ba = P.lw + LW_A2 + (size_t)c * 64 + 8 * hi; const bf16* bg = P.lw + LW_G2 + (size_t)c * 128 + 8 * hi;
#pragma unroll
        for (int ks = 0; ks < 4; ++ks) { accW = __builtin_amdgcn_mfma_f32_32x32x16_bf16(ldsB128(ap + ks * 32), *(const GAS bf16x8v*)(bw + ks * 16), accW, 0, 0, 0);
                                         accA = __builtin_amdgcn_mfma_f32_32x32x16_bf16(ldsB128(ap + 128 + ks * 32), *(const GAS bf16x8v*)(ba + ks * 16), accA, 0, 0, 0); }
#pragma unroll
        for (int ks = 0; ks < 8; ++ks) accG = __builtin_amdgcn_mfma_f32_32x32x16_bf16(ldsB128(ap + 256 + ks * 32), *(const GAS bf16x8v*)(bg + ks * 16), accG, 0, 0, 0);
        if (w.layer > 0) { const LAS unsigned char* vp = lds + PV_V32 + r32 * 80 + hi * 16; const bf16* bv = P.lw + LW_V2 + (size_t)c * 32 + 8 * hi;
#pragma unroll
            for (int ks = 0; ks < 2; ++ks) accV = __builtin_amdgcn_mfma_f32_32x32x16_bf16(ldsB128(vp + ks * 32), *(const GAS bf16x8v*)(bv + ks * 16), accV, 0, 0, 0); }
        {
            bf16* gp = P.G + (m0 + 4 * hi) * RW + c;
#pragma unroll
            for (int r = 0; r < 16; ++r) gp[((r & 3) + 8 * (r >> 2)) * RW] = (bf16)(pg8::cvt_pk_vis(accG[r], accG[r]) & 0xffffu); }
        const float w0c = w.w0[c], a0c = w.a0[c], kac = w.k_a[c], v0c = (w.layer > 0) ? w.v0[c] : 0.f;
        float dec[16], av[16];
#pragma unroll
        for (int r = 0; r < 16; ++r) { const float w_log = -softplusf_(-(accW[r] + w0c)) - 0.5f; dec[r] = fexp_(-fexp_(w_log)); av[r] = sigmoidf_(accA[r] + a0c); }
        float Wc[16], Wp[16];
        { float run = 1.f;
#pragma unroll
          for (int q = 0; q < 4; ++q) {
              const float p0 = dec[4 * q], p1 = p0 * dec[4 * q + 1], p2 = p1 * dec[4 * q + 2], p3 = p2 * dec[4 * q + 3];
              auto rr = __builtin_amdgcn_permlane32_swap(__builtin_bit_cast(unsigned, p3), __builtin_bit_cast(unsigned, p3), false, false);
              const unsigned r0_ = rr[0], r1_ = rr[1]; const float gp = (hi == 0) ? __builtin_bit_cast(float, r1_) : __builtin_bit_cast(float, r0_);
              const float E = (hi == 0) ? run : run * gp;
              Wp[4 * q] = E; Wc[4 * q] = E * p0; Wp[4 * q + 1] = Wc[4 * q]; Wc[4 * q + 1] = E * p1; Wp[4 * q + 2] = Wc[4 * q + 1]; Wc[4 * q + 2] = E * p2; Wp[4 * q + 3] = Wc[4 * q + 2]; Wc[4 * q + 3] = E * p3;
              run = run * (p3 * gp);
          }
          if (hi == 0) P.Wd[(size_t)unit * RW + c] = run; }
        if (w.layer > 0) {
            float vv[16], vf[16];
#pragma unroll
            for (int r = 0; r < 16; ++r) { const size_t o = (m0 + (r & 3) + 8 * (r >> 2) + 4 * hi) * RW + c; vv[r] = P.V[o]; vf[r] = P.VF[o]; }
#pragma unroll
            for (int r = 0; r < 16; ++r) { const size_t o = (m0 + (r & 3) + 8 * (r >> 2) + 4 * hi) * RW + c; P.V[o] = vv[r] + (vf[r] - vv[r]) * sigmoidf_(accV[r] + v0c); } }
#pragma unroll
        for (int r = 0; r < 16; ++r) { const int tok = (r & 3) + 8 * (r >> 2) + 4 * hi; const size_t o = (m0 + tok) * RW + c;
            const float rq = chl[tok * 256], kr = chl[32 * 256 + tok * 256], nk = chl[2 * 32 * 256 + tok * 256];
            const float iW = frcp_(Wc[r]);
            P.K[o] = kr * (1.f + (av[r] - 1.f) * kac) * iW; P.Bv[o] = -nk * av[r] * iW; P.A[o] = nk * Wp[r]; P.R[o] = rq * Wc[r]; }
        __syncthreads();
    }
#undef PREP_ISSUE
#undef PREP_FIN
#undef R_BODY
#undef K_BODY
#undef KK_LOAD
#undef PREP_STEP1_VARS
    if (tid < 448) {
        const int c = 4 * tid; const bf16* ub = u + m0 * DINP + U_XBC + c;
        f32x4 wt[4];
#pragma unroll
        for (int ch = 0; ch < 4; ++ch) wt[ch] = *(const GAS f32x4*)(w.conv_w + (size_t)(c + ch) * 4);
        const f32x4 cb = *(const GAS f32x4*)(w.conv_b + c);
        const f32x4 z4 = {0.f, 0.f, 0.f, 0.f};
        f32x4 x0 = (t0 >= 3) ? ld4bf(ub - 3 * (size_t)DINP) : z4, x1 = (t0 >= 2) ? ld4bf(ub - 2 * (size_t)DINP) : z4, x2 = (t0 >= 1) ? ld4bf(ub - (size_t)DINP) : z4;
        v2u xr[32];
#pragma unroll
        for (int tt = 0; tt < 32; ++tt) xr[tt] = *(const GAS v2u*)(ub + (size_t)tt * DINP);
#pragma unroll
        for (int tt = 0; tt < 32; ++tt) {
            const f32x4 x3 = cvt4bf(xr[tt]);
            f32x4 y;
#pragma unroll
            for (int ch = 0; ch < 4; ++ch) y[ch] = siluf_(cb[ch] + wt[ch][0] * x0[ch] + wt[ch][1] * x1[ch] + wt[ch][2] * x2[ch] + wt[ch][3] * x3[ch]);
            { v2u o; o.x = pg8::cvt_pk_bf16(y[0], y[1]); o.y = pg8::cvt_pk_bf16(y[2], y[3]);
              bf16* d = (c < 768) ? P.XBC + (m0 + tt) * 768 + c : (c >= 1280) ? P.sC + (m0 + tt) * 512 + (c - 1280) : P.sB + (m0 + tt) * 512 + (c - 768); *(GAS v2u*)d = o; }
            x0 = x1; x1 = x2; x2 = x3;
        }
    } else if (tid < 448 + SH) {
        const int h = tid - 448; const float bias = w.dt_bias[h];
        float dv[32];
#pragma unroll
        for (int tt = 0; tt < 32; ++tt) dv[tt] = bf2f(u[(m0 + tt) * DINP + U_DT + h]);
#pragma unroll
        for (int tt = 0; tt < 32; ++tt) P.DT[(m0 + tt) * SH + h] = softplusf_(dv[tt] + bias);
    }
#define ROPE_IDX(idx_) const int tl = (idx_) / 264, sl = (idx_) - tl * 264; const size_t m = m0 + tl; const int hh = sl >> 3, j0 = (sl & 7) * 4; \
        const int so = (hh < 8) ? U_Q + hh * 64 : (hh < 16) ? U_K + (hh - 8) * 64 : (hh < 32) ? U_IQ + (hh - 16) * 64 : U_IK; const bf16* src = u + m * DINP + so + j0;
#define ROPE_OUT(x1r, x2r, cv, sv) { const f32x4 x1 = cvt4bf(x1r), x2 = cvt4bf(x2r); \
        bf16* dst = (hh < 8) ? P.Q + m * AW + hh * 64 : (hh < 16) ? P.Kb + m * AW + (hh - 8) * 64 : (hh < 32) ? P.IQ + m * 1024 + (hh - 16) * 64 : P.IK + m * 64; \
        const float sc = (hh < 8) ? ATT_C2 : 1.f; const f32x4 o1 = (x1 * cv - x2 * sv) * sc, o2 = (x2 * cv + x1 * sv) * sc; \
        v2u a; a.x = pg8::cvt_pk_bf16(o1[0], o1[1]); a.y = pg8::cvt_pk_bf16(o1[2], o1[3]); *(GAS v2u*)(dst + j0) = a; \
        v2u b; b.x = pg8::cvt_pk_bf16(o2[0], o2[1]); b.y = pg8::cvt_pk_bf16(o2[2], o2[3]); *(GAS v2u*)(dst + j0 + 32) = b; }
#pragma unroll 1
    for (int bt = 0; bt < 2; ++bt) {
        v2u xa[8], xb[8]; f32x4 cva[8], sva[8];
#pragma unroll
        for (int i = 0; i < 8; ++i) { ROPE_IDX(tid + NTHR * (8 * bt + i)) xa[i] = *(const GAS v2u*)src; xb[i] = *(const GAS v2u*)(src + 32); cva[i] = *(const GAS f32x4*)(P.rc + m * 32 + j0); sva[i] = *(const GAS f32x4*)(P.rs + m * 32 + j0); }
#pragma unroll
        for (int i = 0; i < 8; ++i) { ROPE_IDX(tid + NTHR * (8 * bt + i)) (void)src; ROPE_OUT(xa[i], xb[i], cva[i], sva[i]) }
    }
    if (tid < 256) { ROPE_IDX(tid + NTHR * 16) const v2u xa = *(const GAS v2u*)src, xb = *(const GAS v2u*)(src + 32); const f32x4 cv = *(const GAS f32x4*)(P.rc + m * 32 + j0), sv = *(const GAS f32x4*)(P.rs + m * 32 + j0); ROPE_OUT(xa, xb, cv, sv) }
#undef ROPE_IDX
#undef ROPE_OUT
    v2u vcp[8];
#pragma unroll
    for (int i = 0; i < 8; ++i) {
        const int idx = tid + NTHR * i, tl = idx >> 7, j0 = (idx & 127) * 4; const size_t m = m0 + tl;
        vcp[i] = *(const GAS v2u*)(u + m * DINP + U_V + j0); }
#pragma unroll
    for (int i = 0; i < 8; ++i) { const int idx = tid + NTHR * i, tl = idx >> 7, j0 = (idx & 127) * 4; const size_t m = m0 + tl; *(GAS v2u*)(P.Vb + m * AW + j0) = vcp[i]; }
    if (tid < 128) { const int tl = tid >> 2, j0 = (tid & 3) * 4; const size_t m = m0 + tl; const f32x4 x = ld4bf(u + m * DINP + U_IW + j0); *(GAS f32x4*)(P.IW + m * 16 + j0) = x * (0.25f * 0.125f); }
    __syncthreads();
}

constexpr int SC_CH = 32;
constexpr int SC_COEF = SC_CH * 4 * 64 * 4;
constexpr int SC_VS = SC_CH + 4;
constexpr int SC_VT = 32 * SC_VS * 4;
constexpr int SC_YB = SC_CH * 4 * 32 * 4;
constexpr int SC_WE = 256;
constexpr int SC_BUF = SC_COEF + SC_VT + SC_YB + SC_WE;
static_assert(2 * SC_BUF <= RING_BYTES, "scan lds");
__device__ __forceinline__ float row8_sum(float x) {
    x += dpp_f<0xB1>(x); x += dpp_f<0x4E>(x); x += dpp_f<0x141>(x); return x;
}
__device__ __forceinline__ void row16_sum4(float& a, float& b, float& c, float& d, float a1, float b1, float c1, float d1) {
    asm("v_add_f32_e32 %0, %0, %4\n\tv_add_f32_e32 %1, %1, %5\n\tv_add_f32_e32 %2, %2, %6\n\tv_add_f32_e32 %3, %3, %7\n\t"
        "v_add_f32_dpp %0, %0, %0 quad_perm:[1,0,3,2] row_mask:0xf bank_mask:0xf\n\tv_add_f32_dpp %1, %1, %1 quad_perm:[1,0,3,2] row_mask:0xf bank_mask:0xf\n\t"
        "v_add_f32_dpp %2, %2, %2 quad_perm:[1,0,3,2] row_mask:0xf bank_mask:0xf\n\tv_add_f32_dpp %3, %3, %3 quad_perm:[1,0,3,2] row_mask:0xf bank_mask:0xf\n\t"
        "v_add_f32_dpp %0, %0, %0 quad_perm:[2,3,0,1] row_mask:0xf bank_mask:0xf\n\tv_add_f32_dpp %1, %1, %1 quad_perm:[2,3,0,1] row_mask:0xf bank_mask:0xf\n\t"
        "v_add_f32_dpp %2, %2, %2 quad_perm:[2,3,0,1] row_mask:0xf bank_mask:0xf\n\tv_add_f32_dpp %3, %3, %3 quad_perm:[2,3,0,1] row_mask:0xf bank_mask:0xf\n\t"
        "v_add_f32_dpp %0, %0, %0 row_half_mirror row_mask:0xf bank_mask:0xf\n\tv_add_f32_dpp %1, %1, %1 row_half_mirror row_mask:0xf bank_mask:0xf\n\t"
        "v_add_f32_dpp %2, %2, %2 row_half_mirror row_mask:0xf bank_mask:0xf\n\tv_add_f32_dpp %3, %3, %3 row_half_mirror row_mask:0xf bank_mask:0xf\n\t"
        "v_add_f32_dpp %0, %0, %0 row_mirror row_mask:0xf bank_mask:0xf\n\tv_add_f32_dpp %1, %1, %1 row_mirror row_mask:0xf bank_mask:0xf\n\t"
        "v_add_f32_dpp %2, %2, %2 row_mirror row_mask:0xf bank_mask:0xf\n\tv_add_f32_dpp %3, %3, %3 row_mirror row_mask:0xf bank_mask:0xf"
        : "+v"(a), "+v"(b), "+v"(c), "+v"(d) : "v"(a1), "v"(b1), "v"(c1), "v"(d1));
}
__device__ __forceinline__ void row16_sum2_quad2(float& a, float& b, float& c, float& d, float a1, float b1, float c1, float d1) {
    asm("v_add_f32_e32 %0, %0, %4\n\tv_add_f32_e32 %1, %1, %5\n\tv_add_f32_e32 %2, %2, %6\n\tv_add_f32_e32 %3, %3, %7\n\t"
        "v_add_f32_dpp %0, %0, %0 quad_perm:[1,0,3,2] row_mask:0xf bank_mask:0xf\n\tv_add_f32_dpp %1, %1, %1 quad_perm:[1,0,3,2] row_mask:0xf bank_mask:0xf\n\t"
        "v_add_f32_dpp %2, %2, %2 quad_perm:[1,0,3,2] row_mask:0xf bank_mask:0xf\n\tv_add_f32_dpp %3, %3, %3 quad_perm:[1,0,3,2] row_mask:0xf bank_mask:0xf\n\t"
        "v_add_f32_dpp %0, %0, %0 quad_perm:[2,3,0,1] row_mask:0xf bank_mask:0xf\n\tv_add_f32_dpp %1, %1, %1 quad_perm:[2,3,0,1] row_mask:0xf bank_mask:0xf\n\t"
        "v_add_f32_dpp %2, %2, %2 quad_perm:[2,3,0,1] row_mask:0xf bank_mask:0xf\n\tv_add_f32_dpp %3, %3, %3 quad_perm:[2,3,0,1] row_mask:0xf bank_mask:0xf\n\t"
        "v_add_f32_dpp %0, %0, %0 row_half_mirror row_mask:0xf bank_mask:0xf\n\tv_add_f32_dpp %1, %1, %1 row_half_mirror row_mask:0xf bank_mask:0xf\n\ts_nop 0\n\t"
        "v_add_f32_dpp %0, %0, %0 row_mirror row_mask:0xf bank_mask:0xf\n\tv_add_f32_dpp %1, %1, %1 row_mirror row_mask:0xf bank_mask:0xf"
        : "+v"(a), "+v"(b), "+v"(c), "+v"(d) : "v"(a1), "v"(b1), "v"(c1), "v"(d1));
}
__device__ __forceinline__ f32x2 dot4h(const f32x4 s, const f32x4 c) { const f32x2 l = s.xy * c.xy; return s.zw * c.zw + l; }
__device__ __forceinline__ void rwkv_scan_unit(Frame& F, int unit, const float* R, const float* Wend, const float* K, const float* V, const float* A, const float* Bv, float* Y) {
    const int chain = unit >> 1, rh = unit & 1, b = chain / RH, h = chain % RH;
    int tid = F.tid; asm volatile("" : "+v"(tid));
    const int lane = tid & 63, wave = F.wave;
    const size_t base = (size_t)b * T * RW + h * 64;
    LAS unsigned char* lds = F.lds;
    const bool helper = wave >= 4; const int ht = tid - 256;
    f32x4 pre[8]; f32x4 prev_, prew_;
    const float* gsrc[4] = {A, Bv, K, R};
    auto issue_loads = [&](int c) {
#pragma unroll
        for (int i = 0; i < 8; ++i) { const int idx = ht + 256 * i, arr = idx >> 9, step = (idx >> 4) & 31, part = idx & 15;
            pre[i] = *(const GAS f32x4*)(gsrc[arr] + base + (size_t)(c * SC_CH + step) * RW + part * 4); }
        prev_ = *(const GAS f32x4*)(V + base + (size_t)(c * SC_CH + (ht >> 3)) * RW + 32 * rh + (ht & 7) * 4);
        if (ht < 16) prew_ = *(const GAS f32x4*)(Wend + ((size_t)(b * (T / SC_CH) + c)) * RW + h * 64 + ht * 4);
    };
    auto store_lds = [&](int buf) {
        LAS float* cf = (LAS float*)(lds + buf * SC_BUF);
#pragma unroll
        for (int i = 0; i < 8; ++i) { const int idx = ht + 256 * i, arr = idx >> 9, step = (idx >> 4) & 31, part = idx & 15;
            *(LAS f32x4*)(cf + (step * 4 + arr) * 64 + part * 4) = pre[i]; }
        LAS float* vt = (LAS float*)(lds + buf * SC_BUF + SC_COEF);
#pragma unroll
        for (int j = 0; j < 4; ++j) vt[((ht & 7) * 4 + j) * SC_VS + (ht >> 3)] = prev_[j];
        if (ht < 16) *(LAS f32x4*)(lds + buf * SC_BUF + SC_COEF + SC_VT + SC_YB + ht * 16) = prew_;
    };
    if (helper) { issue_loads(0); store_lds(0); }
    __syncthreads();
    const int rp = lane >> 4, c4 = lane & 15, row0 = 8 * (wave & 3) + 2 * rp;
    f32x4 s0 = {0.f, 0.f, 0.f, 0.f}, s1 = {0.f, 0.f, 0.f, 0.f};
    constexpr int NCH = T / SC_CH;
#pragma unroll 1
    for (int c = 0; c < NCH; ++c) {
        const int buf = c & 1;
        if (helper) { if (c + 1 < NCH) issue_loads(c + 1); }
        else {
            const LAS float* cf = (const LAS float*)(lds + buf * SC_BUF) + c4 * 4;
            const LAS float* vt0 = (const LAS float*)(lds + buf * SC_BUF + SC_COEF) + row0 * SC_VS; const LAS float* vt1 = vt0 + SC_VS;
            LAS float* yb = (LAS float*)(lds + buf * SC_BUF + SC_COEF + SC_VT) + (c4 >> 2) * 32 + row0;
            f32x4 ca = *(const LAS f32x4*)(cf), cb = *(const LAS f32x4*)(cf + 64), ck = *(const LAS f32x4*)(cf + 128), cq = *(const LAS f32x4*)(cf + 192);
            f32x4 pq = cq;
            f32x4 na = *(const LAS f32x4*)(cf + 256), nb = *(const LAS f32x4*)(cf + 256 + 64), nk = *(const LAS f32x4*)(cf + 256 + 128), nq = *(const LAS f32x4*)(cf + 256 + 192);
            f32x4 va_[SC_CH / 4], vb_[SC_CH / 4];
#pragma unroll
            for (int g4 = 0; g4 < SC_CH / 4; ++g4) { va_[g4] = *(const LAS f32x4*)(vt0 + g4 * 4); vb_[g4] = *(const LAS f32x4*)(vt1 + g4 * 4); }
#pragma unroll
            for (int g4 = 0; g4 < SC_CH / 4; ++g4) {
                const f32x4 v40 = va_[g4], v41 = vb_[g4];
#pragma unroll
                for (int j = 0; j < 4; ++j) {
                    const int st = g4 * 4 + j; const LAS float* cn = cf + ((st + 2) & (SC_CH - 1)) * 256;
                    const f32x4 ma = *(const LAS f32x4*)(cn), mb = *(const LAS f32x4*)(cn + 64), mk = *(const LAS f32x4*)(cn + 128), mq = *(const LAS f32x4*)(cn + 192);
                    __builtin_amdgcn_sched_barrier(0);
                    const float vv0 = v40[j], vv1 = v41[j];
                    const f32x2 pa0 = dot4h(s0, ca), pa1 = dot4h(s1, ca);
                    const f32x2 py0 = dot4h(s0, pq), py1 = dot4h(s1, pq);
                    const f32x4 t0 = s0 + ck * vv0, t1 = s1 + ck * vv1;
                    float sa0 = pa0.x, sa1 = pa1.x, yp0 = py0.x, yp1 = py1.x;
                    row16_sum2_quad2(sa0, sa1, yp0, yp1, pa0.y, pa1.y, py0.y, py1.y);
                    s0 = t0 + cb * sa0; s1 = t1 + cb * sa1;
                    if (st > 0) asm volatile("ds_write_b32 %0, %1 offset:%c3\n\tds_write_b32 %0, %2 offset:%c4" :: "v"(yb), "v"(yp0), "v"(yp1), "i"((st - 1) * 512), "i"((st - 1) * 512 + 4) : "memory");
                    pq = cq; ca = na; cb = nb; ck = nk; cq = nq; na = ma; nb = mb; nk = mk; nq = mq;
                }
            }
            {
                const f32x4 py0 = s0 * pq, py1 = s1 * pq;
                float yp0 = (py0[0] + py0[1]) + (py0[2] + py0[3]), yp1 = (py1[0] + py1[1]) + (py1[2] + py1[3]);
                yp0 += dpp_f<0xB1>(yp0); yp1 += dpp_f<0xB1>(yp1); yp0 += dpp_f<0x4E>(yp0); yp1 += dpp_f<0x4E>(yp1);
                yb[(SC_CH - 1) * 128] = yp0; yb[(SC_CH - 1) * 128 + 1] = yp1;
                const f32x4 we = *(const LAS f32x4*)((const LAS float*)(lds + buf * SC_BUF + SC_COEF + SC_VT + SC_YB) + c4 * 4); s0 = s0 * we; s1 = s1 * we; }
        }
        if (helper && c + 1 < NCH) store_lds(buf ^ 1);
        __syncthreads();
        if (helper) { const LAS float* yb = (const LAS float*)(lds + buf * SC_BUF + SC_COEF + SC_VT); const int ys = ht >> 3, yp = ht & 7; const LAS float* yq = yb + ys * 128 + yp * 4;
            const f32x4 yv = (*(const LAS f32x4*)(yq) + *(const LAS f32x4*)(yq + 32)) + (*(const LAS f32x4*)(yq + 64) + *(const LAS f32x4*)(yq + 96));
            *(GAS f32x4*)(Y + base + (size_t)(c * SC_CH + ys) * RW + 32 * rh + yp * 4) = yv; }
    }
    __syncthreads();
}
__device__ __forceinline__ void rwkv_post_phase(Frame& F, const MixW& w, const float* Y, const float* R, const float* K, const float* V, const bf16* G, bf16* cat) {
    int lane = F.lane; asm volatile("" : "+v"(lane));
    const int gw = F.vcu * NWAVES + F.wave, NGW = F.G * NWAVES;
    const int hq = lane >> 4, l16 = lane & 15;
#pragma unroll 1
    for (int m = gw; m < M; m += NGW) {
        f32x4 y4[3], r4[3], k4[3], v4[3], g4[3];
#pragma unroll
        for (int it = 0; it < 3; ++it) { const int c = (4 * it + hq) * 64 + 4 * l16; const size_t o = (size_t)m * RW + c;
            y4[it] = *(const GAS f32x4*)(Y + o); r4[it] = *(const GAS f32x4*)(R + o); k4[it] = *(const GAS f32x4*)(K + o); v4[it] = *(const GAS f32x4*)(V + o); g4[it] = ld4bf(G + o); }
#pragma unroll
        for (int it = 0; it < 3; ++it) {
            const int c = (4 * it + hq) * 64 + 4 * l16;
            const f32x4 rk = *(const GAS f32x4*)(w.r_k + c), lw = *(const GAS f32x4*)(w.ln_w + c), lb = *(const GAS f32x4*)(w.ln_b + c);
            const float mean = row16_sum((y4[it][0] + y4[it][1]) + (y4[it][2] + y4[it][3])) * (1.f / 64.f);
            const f32x4 d = y4[it] - mean;
            const float var = row16_sum((d[0] * d[0] + d[1] * d[1]) + (d[2] * d[2] + d[3] * d[3])) * (1.f / 64.f);
            const float rstd = __builtin_amdgcn_rsqf(var + 64e-5f);
            const f32x4 rkk = r4[it] * k4[it] * rk;
            const float bon = row16_sum((rkk[0] + rkk[1]) + (rkk[2] + rkk[3]));
            const f32x4 ov = ((d * rstd) * lw + lb + v4[it] * bon) * g4[it];
            v2u ob; ob.x = pg8::cvt_pk_bf16(ov[0], ov[1]); ob.y = pg8::cvt_pk_bf16(ov[2], ov[3]);
            *(GAS v2u*)(cat + (size_t)m * D + AW + c) = ob;
        }
    }
}

#define XW ((bf16*)(ws + WS_XW))
#define H ((bf16*)(ws + WS_H))
#define CAT ((bf16*)(ws + WS_H))
#define ACT ((bf16*)(ws + WS_BIG))
#define UU ((bf16*)(ws + WS_BIG))
#define ROPC ((const float*)(ws + WS_ROPC))
#define ROPS ((const float*)(ws + WS_ROPS))
#define aQ ((bf16*)(ws + AT_Q))
#define aK ((bf16*)(ws + AT_K))
#define aV ((bf16*)(ws + AT_V))
#define aIQ ((bf16*)(ws + AT_IQ))
#define aIK ((bf16*)(ws + AT_IK))
#define aIW ((float*)(ws + AT_IW))
#define aMK ((unsigned long long*)(ws + AT_MK))
#define mR ((float*)(ws + MX_R))
#define mW ((float*)(ws + MX_W))
#define mKK ((float*)(ws + MX_KK))
#define mV ((float*)(ws + MX_V))
#define mA ((float*)(ws + MX_A))
#define mB ((float*)(ws + MX_B))
#define mG ((bf16*)(ws + MX_G))
#define mVF ((float*)(ws + MX_VF))
#define mYR ((float*)(ws + MX_YR))
#define mXBC ((bf16*)(ws + MX_XBC))
#define mDT ((float*)(ws + MX_DT))
#define sBp ((bf16*)(ws + SS_B))
#define sCp ((bf16*)(ws + SS_C))
#define sST ((float*)(ws + SS_ST))
#define sCS ((float*)(ws + SS_CS))
#define sTOT ((float*)(ws + SS_TOT))
#define mYS ((float*)(ws + MX_YS))
#define mYS2 ((float*)(ws + MX_YS2))
#define MIXW_SETUP() MixW w; \
    w.mu = (const float*)args.in[11] + (size_t)L * RC; w.w0 = (const float*)args.in[12] + (size_t)L * RW; w.w2 = (const float*)args.in[13] + (size_t)L * 64 * RW; \
    w.a0 = (const float*)args.in[14] + (size_t)L * RW; w.a2 = (const float*)args.in[15] + (size_t)L * 64 * RW; w.g2 = (const float*)args.in[16] + (size_t)L * 128 * RW; \
    w.k_k = (const float*)args.in[17] + (size_t)L * RW; w.k_a = (const float*)args.in[18] + (size_t)L * RW; w.r_k = (const float*)args.in[19] + (size_t)L * RW; \
    w.ln_w = (const float*)args.in[20] + (size_t)L * RW; w.ln_b = (const float*)args.in[21] + (size_t)L * RW; \
    w.v0 = (const float*)args.in[22]; w.v1 = (const float*)args.in[23]; w.v2 = (const float*)args.in[24]; \
    w.conv_w = (const float*)args.in[25] + (size_t)L * SCD * 4; w.conv_b = (const float*)args.in[26] + (size_t)L * SCD; w.dt_bias = (const float*)args.in[27] + (size_t)L * SH; \
    w.a_log = (const float*)args.in[28] + (size_t)L * SH; w.d_skip = (const float*)args.in[29] + (size_t)L * SH; w.norm_w = (const float*)args.in[30] + (size_t)L * SW; w.layer = L;
#define MODP ((const float*)(ws + WS_MOD) + (size_t)L * 4 * NMODC)
#define NGP ((const float*)args.in[5] + (size_t)L * 3 * D)
#define PH_BEGIN(K) if (lo <= (K) && (K) < hi) { asm volatile("" : "+v"(F.tid), "+v"(F.lane)); asm volatile("" : "+s"(F.wave), "+s"(ws), "+s"(F.G), "+s"(F.vcu)); int bid = __builtin_amdgcn_readfirstlane(blockIdx.x); asm volatile("" : "+s"(bid));
#define PH_END(K) if ((K) + 1 < hi) xcd_barrier(bar, F.tid); }
constexpr int PH_PER_LAYER = 12, PH_FINAL = 1 + 2 * PH_PER_LAYER;

template <int L, int FI> __device__ __forceinline__ void ffn_phases(Frame& F, const Args& args, unsigned char*& ws, const XcdBarrier& bar, const int lo, const int hi) {
    constexpr int K0 = 1 + L * PH_PER_LAYER + (FI == 0 ? 0 : 9);
    constexpr size_t lf = (size_t)L * 2 + FI;
    if constexpr (L == 0 && FI == 0) {
    PH_BEGIN(K0) { norm_mod_phase(F, (const float*)args.in[0], NGP, MODP, MODP + D, H); } PH_END(K0) }
    PH_BEGIN(K0 + 1) { pg8::Gemm g{H, (const bf16*)(ws + WS_WGU + lf * SZ_WGU), M, 2 * FF, D}; pg8::StaticOrder S; S.init(M, 2 * FF, F.G, bid);
        pg8::EpiSwiGLU E{ACT, FF}; pg8::gemm_phase<pg8::EpiSwiGLU, pg8::StaticOrder, true, true>(F.lds + RING_OFF, g, S, E, F.tid);
        if (bid >= 128) convert_slot(F, args, ws, 2 * L + FI, bid); } PH_END(K0 + 1)
    PH_BEGIN(K0 + 2) { constexpr bool BF = (L == 0 && FI == 0); const void* xf = BF ? (const void*)args.in[0] : (const void*)XW;
        pg8::Gemm g{ACT, (const bf16*)(ws + WS_WD + lf * SZ_WD), M, D, FF}; pg8::StaticOrder S; S.init(M, D, F.G, bid);
        if constexpr (FI == 0) {
            pg8::EpiResidNormT<false, BF> E{xf, XW, D, MODP + 2 * D, 0.5f, NGP + D, MODP + 3 * D, MODP + 4 * D, (pg8::bf16_t*)H, (float*)(ws + WS_SSQ), F.ctl + CW_PCNT + (3 * L + 0) * 32, F.ctl + CW_BAR + XB_TMO};
            pg8::gemm_phase<pg8::EpiResidNormT<false, BF>, pg8::StaticOrder, true, true>(F.lds + RING_OFF, g, S, E, F.tid);
        } else if constexpr (L == 0) {
            pg8::EpiResidNormT<false, false> E{xf, XW, D, MODP + 8 * D, 0.5f, (const float*)args.in[5] + (size_t)3 * D, (const float*)(ws + WS_MOD) + (size_t)4 * NMODC, (const float*)(ws + WS_MOD) + (size_t)4 * NMODC + D, (pg8::bf16_t*)H, (float*)(ws + WS_SSQ), F.ctl + CW_PCNT + 2 * 32, F.ctl + CW_BAR + XB_TMO};
            pg8::gemm_phase<pg8::EpiResidNormT<false, false>, pg8::StaticOrder, true, true>(F.lds + RING_OFF, g, S, E, F.tid);
        } else {
            pg8::EpiResidNormT<true, false> E{xf, args.out, D, MODP + 8 * D, 0.5f, (const float*)args.in[31], nullptr, nullptr, nullptr, (float*)(ws + WS_SSQ), F.ctl + CW_PCNT + 5 * 32, F.ctl + CW_BAR + XB_TMO};
            pg8::gemm_phase<pg8::EpiResidNormT<true, false>, pg8::StaticOrder, true, true>(F.lds + RING_OFF, g, S, E, F.tid); } } PH_END(K0 + 2)
}
template <int L> __device__ __forceinline__ void mixer_phases(Frame& F, const Args& args, unsigned char*& ws, const XcdBarrier& bar, const int lo, const int hi) {
    constexpr int K0 = 1 + L * PH_PER_LAYER + 3;
    PH_BEGIN(K0 + 1) { pg8::Gemm g{H, (const bf16*)(ws + WS_WIN + (size_t)L * SZ_WIN), M, DINP, D}; pg8::StaticOrder S; S.init(M, DINP, F.G, bid);
        pg8::EpiBf16U E{UU, DINP}; pg8::gemm_phase<pg8::EpiBf16U, pg8::StaticOrder, true, true>(F.lds + RING_OFF, g, S, E, F.tid); } PH_END(K0 + 1)
    PH_BEGIN(K0 + 2) { MIXW_SETUP()
        PrepBufs P; P.R = mR; P.Wd = mW; P.K = mKK; P.V = mV; P.A = mA; P.Bv = mB; P.G = mG; P.VF = mVF; P.XBC = mXBC; P.DT = mDT; P.sB = sBp; P.sC = sCp;
        P.Q = aQ; P.Kb = aK; P.Vb = aV; P.IQ = aIQ; P.IK = aIK; P.IW = aIW; P.rc = ROPC; P.rs = ROPS; P.lw = (const bf16*)(ws + WS_LW) + (size_t)L * LW_ELEMS;
        for (int u_ = bid; u_ < M / 32; u_ += F.G) { int un = __builtin_amdgcn_readfirstlane(u_); asm volatile("" : "+s"(un)); prep_unit(F, un, UU, w, P); } }
    PH_END(K0 + 2)
    PH_BEGIN(K0 + 3) { MIXW_SETUP()
        constexpr int NSCAN = 96;
        if (bid < NSCAN) { rwkv_scan_unit(F, bid, mR, mW, mKK, (L == 0 ? mVF : mV), mA, mB, mYR); }
        else {
            const int nb = F.G - NSCAN, rb = bid - NSCAN;
            for (int u_ = rb; u_ < 512; u_ += nb) { int un = __builtin_amdgcn_readfirstlane(u_); asm volatile("" : "+s"(un)); idx_unit(F, un, aIQ, aIK, aIW, aMK); }
            for (int u_ = rb; u_ < 128; u_ += nb) { int un = __builtin_amdgcn_readfirstlane(u_); asm volatile("" : "+s"(un)); ssd_pass1_unit(F, un, mXBC, mDT, sBp, sCp, w.a_log, mYS, sST, sCS, sTOT); }
            group_barrier(F.ctl + 2048 + 64 * L, (unsigned)nb, F.ctl + CW_BAR + XB_TMO, F.tid);
            for (int k_ = rb; k_ < 144; k_ += nb) {
                const int k = __builtin_amdgcn_readfirstlane(k_);
                int bh0, q0_, bh1, q1_;
                if (k < 128) { bh0 = k >> 2; bh1 = bh0; const int j = k & 3; q0_ = 7 - j; q1_ = (j == 0) ? -1 : j - 1; }
                else { bh0 = 2 * (k - 128); bh1 = bh0 + 1; q0_ = 3; q1_ = 3; }
                attn_body::attn_unit<8>(bh0 >> 3, bh0 & 7, q0_, (const attn_body::bf16*)aQ, (const attn_body::bf16*)aK, (const attn_body::bf16*)aV, (attn_body::bf16*)CAT, aMK + (size_t)(bh0 >> 3) * 32 * T, F.ldsg, F.tid);
                if (q1_ >= 0) attn_body::attn_unit<8>(bh1 >> 3, bh1 & 7, q1_, (const attn_body::bf16*)aQ, (const attn_body::bf16*)aK, (const attn_body::bf16*)aV, (attn_body::bf16*)CAT, aMK + (size_t)(bh1 >> 3) * 32 * T, F.ldsg, F.tid);
            }
        } }
    PH_END(K0 + 3)
    PH_BEGIN(K0 + 4) { MIXW_SETUP()
        if (bid < 128) ssd_pass2_unit(F, bid, mXBC, UU, sCp, mYS, sST, sCS, sTOT, w.d_skip, w.norm_w, CAT);
        rwkv_post_phase(F, w, mYR, mR, mKK, (L == 0 ? mVF : mV), mG, CAT); }
    PH_END(K0 + 4)
    PH_BEGIN(K0 + 5) { pg8::Gemm g{CAT, (const bf16*)(ws + WS_WOUT + (size_t)L * SZ_WOUT), M, D, D}; pg8::StaticOrder S; S.init(M, D, F.G, bid);
        pg8::EpiResidNormT<false, false> E{XW, XW, D, MODP + 5 * D, 1.0f, NGP + 2 * D, MODP + 6 * D, MODP + 7 * D, (pg8::bf16_t*)H, (float*)(ws + WS_SSQ), F.ctl + CW_PCNT + (3 * L + 1) * 32, F.ctl + CW_BAR + XB_TMO};
        pg8::gemm_phase<pg8::EpiResidNormT<false, false>, pg8::StaticOrder, true, true>(F.lds + RING_OFF, g, S, E, F.tid); } PH_END(K0 + 5)
}

__global__ void __launch_bounds__(NTHR, 2) fwd(Args args) {
    extern __shared__ __attribute__((aligned(16))) unsigned char lds[];
    Frame F;
    F.lds = (LAS unsigned char*)lds; F.ldsg = (char*)lds; F.MISC = (volatile LAS unsigned*)(F.lds + MISC_OFF);
    F.tid = threadIdx.x; F.lane = F.tid & 63; F.wave = __builtin_amdgcn_readfirstlane(F.tid >> 6);
    F.G = gridDim.x; { const int bx = blockIdx.x; F.vcu = (F.G % 8 == 0) ? (bx % 8) * (F.G / 8) + bx / 8 : bx; }
    unsigned char* ws = args.ws;
    F.ctl = (unsigned*)(ws + WS_CTL);
    for (int u = F.tid; u < (LDS_BYTES - LDSCTL_OFF) / 4; u += NTHR) ((LAS unsigned*)(F.lds + LDSCTL_OFF))[u] = 0u;
    __syncthreads();
    XcdBarrier bar = xcd_barrier_post(F.ctl + CW_BAR, F.MISC + 8, F.tid);
    const int lo = args.ph_lo, hi = args.ph_hi;
    PH_BEGIN(0) p0_prologue(F, args); PH_END(0)
    ffn_phases<0, 0>(F, args, ws, bar, lo, hi);
    mixer_phases<0>(F, args, ws, bar, lo, hi);
    ffn_phases<0, 1>(F, args, ws, bar, lo, hi);
    ffn_phases<1, 0>(F, args, ws, bar, lo, hi);
    mixer_phases<1>(F, args, ws, bar, lo, hi);
    ffn_phases<1, 1>(F, args, ws, bar, lo, hi);
}

extern "C" void kernel_launch(void* const* d_in, const int* in_sizes, int n_in, void* d_out, int out_size, void* d_ws, size_t ws_size, hipStream_t stream) {
    static int grid = 0;
    if (grid == 0) {
        if (n_in != 32 || out_size != M * D || ws_size < WS_END) { fprintf(stderr, "kernel_launch: unexpected problem: n_in %d out %d ws %zu (need %zu)\n", n_in, out_size, ws_size, (size_t)WS_END); grid = -1; return; }
        int dev = 0, cus = 0, per_cu = 0;
        if (hipGetDevice(&dev) != hipSuccess || hipDeviceGetAttribute(&cus, hipDeviceAttributeMultiprocessorCount, dev) != hipSuccess) { grid = -1; return; }
        if (hipFuncSetAttribute((const void*)fwd, hipFuncAttributeMaxDynamicSharedMemorySize, LDS_BYTES) != hipSuccess) { fprintf(stderr, "kernel_launch: hipFuncSetAttribute failed\n"); grid = -1; return; }
        if (hipOccupancyMaxActiveBlocksPerMultiprocessor(&per_cu, (const void*)fwd, NTHR, LDS_BYTES) != hipSuccess || per_cu < 1) fprintf(stderr, "kernel_launch: occupancy query says %d\n", per_cu);
        (void)hipGetLastError();
        if (cus != 256) { fprintf(stderr, "kernel_launch: this kernel is laid out for 256 CUs (one 256x256 unit per workgroup in the fused residual epilogues), found %d\n", cus); grid = -1; return; }
        grid = cus;
    }
    if (grid < 0) return;
    (void)hipMemsetAsync((char*)d_ws + WS_CTL, 0, CTL_ZERO_BYTES, stream);
    Args a{};
    for (int i = 0; i < 32; ++i) a.in[i] = d_in[i];
    a.out = (float*)d_out; a.ws = (unsigned char*)d_ws; a.ph_lo = 0; a.ph_hi = PH_FINAL;
    hipLaunchKernelGGL(fwd, dim3(grid), dim3(NTHR), LDS_BYTES, stream, a);
}
```

```cpp
#include <hip/hip_runtime.h>
#include <cstdio>
#include <cstdint>
#include <cmath>
#include <hip/hip_bf16.h>
namespace pg8 {
#define PG8_LAS __attribute__((address_space(3)))
typedef unsigned short bf16_t;
typedef short bf16x8 __attribute__((ext_vector_type(8)));
typedef float f32x4 __attribute__((ext_vector_type(4)));
typedef unsigned u32x4 __attribute__((ext_vector_type(4)));
constexpr int BM = 256, BK = 64, HALF = 128, HTB = HALF * BK * 2  , STAGE_BYTES = 8 * HTB, NXCD = 8, WGM = 8;

__host__ __device__ __forceinline__ int lds_byte(int r, int c) { const int st = (r >> 4) * 2 + (c >> 5), rr = r & 15, cc = c & 31, ob = rr * 64 + cc * 2; return st * 1024 + (ob ^ (((ob >> 9) & 1) << 5)); }
__host__ __device__ __forceinline__ void stage_rc(int b, int& R, int& C) { const int st = b / 1024, sb = b % 1024, swz = sb ^ (((sb >> 9) & 1) << 5); R = (st >> 1) * 16 + swz / 64; C = (st & 1) * 32 + (swz % 64) / 2; }
__host__ __device__ __forceinline__ int perm32(int rho) { const int n = rho >> 4, i = rho & 15; return 8 * (i >> 2) + 4 * n + (i & 3); }

struct Unit { int pm, pn; };
struct Gemm { const bf16_t* A; const bf16_t* Bt; int M, N, K; };

struct StaticOrder {
    int nM, nN, nwg, G, c;
    __host__ __device__ void init(int M, int N, int G_, int c_) { nM = M / BM; nN = N / BM; nwg = nM * nN; G = G_; c = c_; }
    __host__ __device__ bool next(int i, Unit& u) const {
        const long L = (long)i * G + c; if (L >= nwg) return false;
        int wgid = (int)L; { const int q = nwg / NXCD, r = nwg % NXCD, xcd = wgid % NXCD, off = wgid / NXCD; wgid = (xcd < r ? xcd * (q + 1) : r * (q + 1) + (xcd - r) * q) + off; }
        const int nig = WGM * nN, gid = wgid / nig, fm = gid * WGM, gsz = (nM - fm) < WGM ? (nM - fm) : WGM;
        u.pm = fm + ((wgid % nig) % gsz); u.pn = (wgid % nig) / gsz; return true;
    }
    __device__ __forceinline__ void a_ready(const Unit&) const {}
    __device__ __forceinline__ void done(const Unit&) const {}
};

__device__ __forceinline__ unsigned cvt_pk_bf16(float lo, float hi) { unsigned r; asm volatile("v_cvt_pk_bf16_f32 %0, %1, %2" : "=v"(r) : "v"(lo), "v"(hi)); return r; }
typedef float f32x2 __attribute__((ext_vector_type(2)));

template <class Epi, class Sched, bool ALIGN_EPI = false, bool SP2 = false>
__device__ __forceinline__ void gemm_phase(PG8_LAS unsigned char* lds, const Gemm g, const Sched& S, const Epi& E, int tid_in) {
    int tid_ = tid_in; asm volatile("" : "+v"(tid_)); const int tid = tid_, wid = __builtin_amdgcn_readfirstlane(tid >> 6), lane = tid & 63, wr = wid >> 2, wc = wid & 3, fr = lane & 15, fq = lane >> 4;
    const int K = g.K, nt = K / BK;
    unsigned voffA[2], voffB[2];
#pragma unroll
    for (int i = 0; i < 2; ++i) { int R, C; stage_rc(tid * 16 + i * 8192, R, C); const int Rb = Epi::PERM ? ((R & ~31) + perm32(R & 31)) : R;
        voffA[i] = (unsigned)(R * K + C) * 2u; voffB[i] = (unsigned)(Rb * K + C) * 2u; }
    const size_t kstep = (size_t)(BK * 2);
    const size_t hstep = (size_t)HALF * K * 2;
    const size_t tstep = 2 * hstep;
    const unsigned ldsw = (unsigned)wid * 1024u;
    const int aoff = lds_byte(wr * 64 + fr, fq * 8), boff = lds_byte(wc * 32 + fr, fq * 8);
#define PG8_SA(b, h) (((b) * 2 + (h)) * HTB)
#define PG8_SB(b, h) ((4 + (b) * 2 + (h)) * HTB)
#define PG8_STAGE(bufoff, gbase, voff) do { _Pragma("unroll") for (int _i = 0; _i < 2; ++_i) \
        __builtin_amdgcn_global_load_lds((const unsigned*)((const char*)(gbase) + (voff)[_i]), (PG8_LAS unsigned*)(lds + (bufoff) + ldsw + _i * 8192), 16, 0, 0); } while (0)
#define PG8_LDA(dst, b, h) do { _Pragma("unroll") for (int m = 0; m < 4; ++m) _Pragma("unroll") for (int k = 0; k < 2; ++k) dst[m][k] = *(const PG8_LAS bf16x8*)(lds + PG8_SA(b, h) + aoff + m * 2048 + k * 1024); } while (0)
#define PG8_LDB(dst, b, h) do { _Pragma("unroll") for (int n = 0; n < 2; ++n) _Pragma("unroll") for (int k = 0; k < 2; ++k) dst[n][k] = *(const PG8_LAS bf16x8*)(lds + PG8_SB(b, h) + boff + n * 2048 + k * 1024); } while (0)
#define PG8_MMA(ai, bj, At, Bt) do { __builtin_amdgcn_s_setprio(1); _Pragma("unroll") for (int m = 0; m < 4; ++m) _Pragma("unroll") for (int n = 0; n < 2; ++n) _Pragma("unroll") for (int k = 0; k < 2; ++k) \
        acc[ai][bj][m][n] = __builtin_amdgcn_mfma_f32_16x16x32_bf16(Bt[n][k], At[m][k], acc[ai][bj][m][n], 0, 0, 0); __builtin_amdgcn_s_setprio(0); } while (0)
#define PG8_WAIT_V(n) asm volatile("s_waitcnt vmcnt(" #n ")" ::: "memory")
#define PG8_WAIT_L(n) asm volatile("s_waitcnt lgkmcnt(" #n ")" ::: "memory")
#define PG8_BAR __builtin_amdgcn_s_barrier()
#define PG8_SCHED __builtin_amdgcn_sched_barrier(0)
    Unit cur, nxt; int ui = 0;
    if (!S.next(0, cur)) return;
    f32x4 acc[2][2][4][2];
#pragma unroll
    for (int a = 0; a < 2; ++a)
#pragma unroll
        for (int b = 0; b < 2; ++b)
#pragma unroll
            for (int m = 0; m < 4; ++m)
#pragma unroll
                for (int n = 0; n < 2; ++n) acc[a][b][m][n] = (f32x4){0.f, 0.f, 0.f, 0.f};
    bf16x8 At[4][2], B0[2][2], B1[2][2];
    const char* cA = (const char*)g.A + (size_t)cur.pm * tstep; const char* cB = (const char*)g.Bt + (size_t)cur.pn * tstep;
    S.a_ready(cur);
    if constexpr (SP2) {
        PG8_STAGE(PG8_SB(0, 0), cB, voffB); PG8_STAGE(PG8_SB(0, 1), cB + hstep, voffB); PG8_STAGE(PG8_SA(0, 0), cA, voffA); PG8_STAGE(PG8_SA(0, 1), cA + hstep, voffA);
        if (wr == 1) PG8_BAR;
        PG8_WAIT_V(2); PG8_BAR;
        PG8_STAGE(PG8_SB(1, 0), cB + kstep, voffB); PG8_STAGE(PG8_SA(1, 0), cA + kstep, voffA); PG8_STAGE(PG8_SB(1, 1), cB + hstep + kstep, voffB);
        PG8_WAIT_V(6); PG8_BAR;
    } else {
        PG8_STAGE(PG8_SB(0, 0), cB, voffB); PG8_STAGE(PG8_SA(0, 0), cA, voffA); PG8_STAGE(PG8_SB(0, 1), cB + hstep, voffB); PG8_STAGE(PG8_SA(0, 1), cA + hstep, voffA);
        if (wr == 1) PG8_BAR;
        PG8_WAIT_V(4); PG8_BAR;
        PG8_STAGE(PG8_SB(1, 0), cB + kstep, voffB); PG8_STAGE(PG8_SA(1, 0), cA + kstep, voffA); PG8_STAGE(PG8_SB(1, 1), cB + hstep + kstep, voffB);
        PG8_WAIT_V(6); PG8_BAR;
    }
    for (;;) {
        const bool has_next = S.next(ui + 1, nxt);
        const char* nA = has_next ? (const char*)g.A + (size_t)nxt.pm * tstep : cA; const char* nB = has_next ? (const char*)g.Bt + (size_t)nxt.pn * tstep : cB;
        for (int t = 0; t < nt; t += 2) {
            const bool last = (t == nt - 2);
            const char* a1 = cA + (size_t)(t + 1) * kstep;
            const char* a2 = last ? nA : cA + (size_t)(t + 2) * kstep; const char* b2 = last ? nB : cB + (size_t)(t + 2) * kstep;
            const char* a3 = a2 + kstep; const char* b3 = b2 + kstep;
            if (last && has_next) S.a_ready(nxt);
            if constexpr (SP2) {
            PG8_LDB(B0, 0, 0); PG8_LDB(B1, 0, 1); PG8_SCHED; PG8_LDA(At, 0, 0); PG8_STAGE(PG8_SA(1, 1), a1 + hstep, voffA);
            PG8_WAIT_V(8); PG8_WAIT_L(0); PG8_BAR; PG8_MMA(0, 0, At, B0); PG8_MMA(0, 1, At, B1); PG8_BAR; PG8_SCHED;
            PG8_LDA(At, 0, 1); PG8_STAGE(PG8_SB(0, 0), b2, voffB); PG8_STAGE(PG8_SB(0, 1), b2 + hstep, voffB); PG8_STAGE(PG8_SA(0, 0), a2, voffA);
            PG8_WAIT_V(8); PG8_WAIT_L(0); PG8_BAR; PG8_MMA(1, 0, At, B0); PG8_MMA(1, 1, At, B1); PG8_BAR; PG8_SCHED;
            PG8_LDB(B0, 1, 0); PG8_LDB(B1, 1, 1); PG8_SCHED; PG8_LDA(At, 1, 0); PG8_STAGE(PG8_SA(0, 1), a2 + hstep, voffA);
            PG8_WAIT_V(8); PG8_WAIT_L(0); PG8_BAR; PG8_MMA(0, 0, At, B0); PG8_MMA(0, 1, At, B1); PG8_BAR; PG8_SCHED;
            PG8_LDA(At, 1, 1); PG8_STAGE(PG8_SB(1, 0), b3, voffB); PG8_STAGE(PG8_SB(1, 1), b3 + hstep, voffB); PG8_STAGE(PG8_SA(1, 0), a3, voffA);
            PG8_WAIT_V(8); PG8_WAIT_L(0); PG8_BAR; PG8_MMA(1, 0, At, B0); PG8_MMA(1, 1, At, B1); PG8_BAR; PG8_SCHED;
            } else {
            PG8_LDB(B0, 0, 0); PG8_SCHED; PG8_LDA(At, 0, 0); PG8_STAGE(PG8_SA(1, 1), a1 + hstep, voffA);
            PG8_WAIT_L(8); PG8_BAR; PG8_WAIT_L(0); PG8_MMA(0, 0, At, B0); PG8_BAR; PG8_SCHED;
            PG8_LDB(B1, 0, 1); PG8_STAGE(PG8_SB(0, 0), b2, voffB);
            PG8_BAR; PG8_WAIT_L(0); PG8_MMA(0, 1, At, B1); PG8_BAR;
            PG8_LDA(At, 0, 1); PG8_STAGE(PG8_SA(0, 0), a2, voffA);
            PG8_BAR; PG8_WAIT_L(0); PG8_MMA(1, 0, At, B0); PG8_BAR; PG8_SCHED;
            PG8_STAGE(PG8_SB(0, 1), b2 + hstep, voffB);
            PG8_WAIT_V(6); PG8_BAR; PG8_MMA(1, 1, At, B1); PG8_BAR;
            PG8_LDB(B0, 1, 0); PG8_SCHED; PG8_LDA(At, 1, 0); PG8_STAGE(PG8_SA(0, 1), a2 + hstep, voffA);
            PG8_WAIT_L(8); PG8_BAR; PG8_WAIT_L(0); PG8_MMA(0, 0, At, B0); PG8_BAR; PG8_SCHED;
            PG8_LDB(B1, 1, 1); PG8_STAGE(PG8_SB(1, 0), b3, voffB);
            PG8_BAR; PG8_WAIT_L(0); PG8_MMA(0, 1, At, B1); PG8_BAR;
            PG8_LDA(At, 1, 1); PG8_STAGE(PG8_SA(1, 0), a3, voffA);
            PG8_BAR; PG8_WAIT_L(0); PG8_MMA(1, 0, At, B0); PG8_BAR; PG8_SCHED;
            PG8_STAGE(PG8_SB(1, 1), b3 + hstep, voffB);
            PG8_WAIT_V(6); PG8_BAR; PG8_MMA(1, 1, At, B1); PG8_BAR;
            }
        }
        if constexpr (ALIGN_EPI) { if (wr == 0) PG8_BAR; }
        if constexpr (!Epi::AFTER_DRAIN) { E(acc, cur, wr, wc, fr, fq); S.done(cur); }
        if (!has_next) break;
#pragma unroll
        for (int a = 0; a < 2; ++a)
#pragma unroll
            for (int b = 0; b < 2; ++b)
#pragma unroll
                for (int m = 0; m < 4; ++m)
#pragma unroll
                    for (int n = 0; n < 2; ++n) acc[a][b][m][n] = (f32x4){0.f, 0.f, 0.f, 0.f};
        cur = nxt; cA = nA; cB = nB; ++ui;
        if constexpr (ALIGN_EPI) { if (wr == 1) PG8_BAR; }
    }
    PG8_WAIT_V(0);
    if constexpr (!ALIGN_EPI) { if (wr == 0) PG8_BAR; }
    PG8_BAR;
    if constexpr (Epi::AFTER_DRAIN) { E.fused(acc, cur, wr, wc, fr, fq, lds, wid, lane); S.done(cur); }
#undef PG8_SA
#undef PG8_SB
#undef PG8_STAGE
#undef PG8_LDA
#undef PG8_LDB
#undef PG8_MMA
#undef PG8_WAIT_V
#undef PG8_WAIT_L
#undef PG8_BAR
#undef PG8_SCHED
}
}
namespace pg8 {
__device__ __forceinline__ float silu_f(float g) { return g * __builtin_amdgcn_rcpf(1.0f + __builtin_amdgcn_exp2f(-1.4426950408889634f * g)); }
struct EpiSwiGLU {
    static constexpr bool PERM = true, AFTER_DRAIN = false;
    bf16_t* O; int ldc;
    __device__ __forceinline__ void operator()(const f32x4 (&acc)[2][2][4][2], const Unit& u, int wr, int wc, int fr, int fq) const {
        const int row0 = u.pm * BM + wr * 64 + fr, col0 = u.pn * HALF + wc * 32 + 8 * fq;
#pragma unroll
        for (int ai = 0; ai < 2; ++ai)
#pragma unroll
            for (int m = 0; m < 4; ++m) { bf16_t* rowp = O + (size_t)(row0 + ai * HALF + m * 16) * ldc + col0;
                const f32x4 g0 = acc[ai][0][m][0], g1 = acc[ai][0][m][1], u0 = acc[ai][1][m][0], u1 = acc[ai][1][m][1];
                f32x4 v0, v1;
#pragma unroll
                for (int j = 0; j < 4; ++j) { v0[j] = silu_f(g0[j]) * u0[j]; v1[j] = silu_f(g1[j]) * u1[j]; }
                u32x4 w; w.x = cvt_pk_bf16(v0[0], v0[1]); w.y = cvt_pk_bf16(v0[2], v0[3]); w.z = cvt_pk_bf16(v1[0], v1[1]); w.w = cvt_pk_bf16(v1[2], v1[3]);
                *(u32x4*)rowp = w; }
    }
};
struct EpiResid {
    static constexpr bool PERM = false, AFTER_DRAIN = false;
    const float* base; float* out; int ldc; const float* gate; float coef;
    __device__ __forceinline__ void operator()(const f32x4 (&acc)[2][2][4][2], const Unit& u, int wr, int wc, int fr, int fq) const {
        const int row0 = u.pm * BM + wr * 64 + fr, col0 = u.pn * BM + wc * 32 + 4 * fq;
        const float* gp = gate + (size_t)(u.pm >> 3) * 18432 + col0;
        f32x4 gv[2][2];
#pragma unroll
        for (int bj = 0; bj < 2; ++bj)
#pragma unroll
            for (int n = 0; n < 2; ++n) gv[bj][n] = *(const f32x4*)(gp + bj * HALF + n * 16) * coef;
#pragma unroll
        for (int ai = 0; ai < 2; ++ai)
#pragma unroll
            for (int m = 0; m < 4; ++m) { const size_t off = (size_t)(row0 + ai * HALF + m * 16) * ldc + col0;
#pragma unroll
                for (int bj = 0; bj < 2; ++bj)
#pragma unroll
                    for (int n = 0; n < 2; ++n) { const f32x4 bs = *(const f32x4*)(base + off + bj * HALF + n * 16); *(f32x4*)(out + off + bj * HALF + n * 16) = bs + acc[ai][bj][m][n] * gv[bj][n]; }
                asm volatile("" ::: "memory"); }
    }
};
typedef float f32x2p_ __attribute__((ext_vector_type(2))); typedef __bf16 bf16x2p_ __attribute__((ext_vector_type(2)));
__device__ __forceinline__ unsigned cvt_pk_vis(float lo, float hi) { f32x2p_ v = {lo, hi}; bf16x2p_ b = __builtin_convertvector(v, bf16x2p_); return __builtin_bit_cast(unsigned, b); }
struct EpiBf16U {
    static constexpr bool PERM = true, AFTER_DRAIN = false;
    bf16_t* O; int ldc;
    __device__ __forceinline__ void operator()(const f32x4 (&acc)[2][2][4][2], const Unit& u, int wr, int wc, int fr, int fq) const {
        const int row0 = u.pm * BM + wr * 64 + fr, col0 = u.pn * BM + wc * 32 + 8 * fq;
#pragma unroll
        for (int ai = 0; ai < 2; ++ai)
#pragma unroll
            for (int m = 0; m < 4; ++m) { bf16_t* rowp = O + (size_t)(row0 + ai * HALF + m * 16) * ldc + col0;
#pragma unroll
                for (int bj = 0; bj < 2; ++bj) { const f32x4 v0 = acc[ai][bj][m][0], v1 = acc[ai][bj][m][1];
                    u32x4 w; w.x = cvt_pk_vis(v0[0], v0[1]); w.y = cvt_pk_vis(v0[2], v0[3]); w.z = cvt_pk_vis(v1[0], v1[1]); w.w = cvt_pk_vis(v1[2], v1[3]);
                    *(u32x4*)(rowp + bj * HALF) = w; } }
    }
};
struct EpiF32 {
    static constexpr bool PERM = false, AFTER_DRAIN = false;
    float* C; int ldc;
    __device__ __forceinline__ void operator()(const f32x4 (&acc)[2][2][4][2], const Unit& u, int wr, int wc, int fr, int fq) const {
        const int row0 = u.pm * BM + wr * 64 + fr, col0 = u.pn * BM + wc * 32 + 4 * fq;
#pragma unroll
        for (int ai = 0; ai < 2; ++ai)
#pragma unroll
            for (int m = 0; m < 4; ++m) { float* rowp = C + (size_t)(row0 + ai * HALF + m * 16) * ldc + col0;
#pragma unroll
                for (int bj = 0; bj < 2; ++bj)
#pragma unroll
                    for (int n = 0; n < 2; ++n) *(f32x4*)(rowp + bj * HALF + n * 16) = acc[ai][bj][m][n]; }
    }
};
}

constexpr int NWAVES = 8, NTHR = 512;
constexpr int Bn = 4, T = 2048, D = 2048, M = Bn * T, FF = 5632, DIN = 7772, DINP = 7936, NMODC = 18432;
constexpr int AH = 8, AW = 512, TOPK = 256;
constexpr int RH = 12, RW = 768, RC = 2560;
constexpr int SH = 12, SW = 768, SG = 4, SCD = 1792;
constexpr int U_Q = 0, U_K = 512, U_V = 1024, U_IQ = 1536, U_IK = 2560, U_IW = 2624, U_RW = 2640, U_Z = 5200, U_XBC = 5968, U_DT = 7760;
constexpr float NORM_EPS = 1e-6f;

constexpr size_t MiB = 1u << 20;
constexpr size_t al256(size_t x) { return (x + 255) & ~(size_t)255; }
constexpr size_t WS_CTL = 0, CTL_ZERO_BYTES = 1 * MiB;
constexpr size_t WS_MOD = WS_CTL + CTL_ZERO_BYTES;
constexpr size_t WS_ROPC = al256(WS_MOD + (size_t)2 * 4 * NMODC * 4);
constexpr size_t WS_ROPS = al256(WS_ROPC + (size_t)M * 32 * 4);
constexpr size_t WS_WGU = al256(WS_ROPS + (size_t)M * 32 * 4);
constexpr size_t SZ_WGU = (size_t)2 * FF * D * 2;
constexpr size_t WS_WD = WS_WGU + 4 * SZ_WGU;
constexpr size_t SZ_WD = (size_t)D * FF * 2;
constexpr size_t WS_WIN = WS_WD + 4 * SZ_WD;
constexpr size_t SZ_WIN = (size_t)DINP * D * 2;
constexpr size_t WS_WOUT = WS_WIN + 2 * SZ_WIN;
constexpr size_t SZ_WOUT = (size_t)D * D * 2;
constexpr size_t WS_XW = WS_WOUT + 2 * SZ_WOUT;
constexpr size_t WS_H = WS_XW + (size_t)M * D * 4;
constexpr size_t WS_BIG = WS_H + (size_t)M * D * 2;
constexpr size_t WS_MIX = WS_BIG + (size_t)M * DINP * 4;
constexpr size_t MX_Q = WS_MIX, MX_K = MX_Q + (size_t)M * AW * 4, MX_IQ = MX_K + (size_t)M * AW * 4, MX_IK = MX_IQ + (size_t)M * 1024 * 4;
constexpr size_t MX_R = MX_IK + (size_t)M * 64 * 4, SZ_R = (size_t)M * RW * 4;
constexpr size_t MX_W = MX_R + SZ_R, MX_KK = MX_W + SZ_R, MX_V = MX_KK + SZ_R, MX_A = MX_V + SZ_R, MX_B = MX_A + SZ_R, MX_G = MX_B + SZ_R, MX_VF = MX_G + SZ_R, MX_YR = MX_VF + SZ_R;
constexpr size_t MX_XBC = MX_YR + SZ_R, MX_DT = MX_XBC + (size_t)M * SCD * 4, MX_YS = al256(MX_DT + (size_t)M * SH * 4);
constexpr size_t MX_YS2 = MX_YS + SZ_R;
constexpr size_t AT_Q = MX_YS2 + SZ_R;
constexpr size_t AT_K = AT_Q + (size_t)M * AW * 2, AT_V = AT_K + (size_t)M * AW * 2;
constexpr size_t AT_IQ = AT_V + (size_t)M * AW * 2;
constexpr size_t AT_IK = AT_IQ + (size_t)M * 1024 * 2;
constexpr size_t AT_IW = AT_IK + (size_t)M * 64 * 2;
constexpr size_t AT_MK = AT_IW + (size_t)M * 16 * 4;
constexpr size_t SS_B = AT_MK + (size_t)4 * 32 * 2048 * 8;
constexpr size_t SS_C = SS_B + (size_t)M * 512 * 2;
constexpr size_t SS_ST = SS_C + (size_t)M * 512 * 2;
constexpr size_t SS_CS = SS_ST + (size_t)4 * 12 * 8 * 64 * 128 * 4;
constexpr size_t SS_TOT = SS_CS + (size_t)M * 12 * 4;
constexpr size_t WS_LW = SS_TOT + 4096;
constexpr size_t LW_W2 = 0, LW_A2 = 768 * 64, LW_G2 = LW_A2 + 768 * 64, LW_V1 = LW_G2 + 768 * 128, LW_V2 = LW_V1 + 32 * 768, LW_ELEMS = LW_V2 + 768 * 32;
constexpr size_t WS_SSQ = al256(WS_LW + 2 * LW_ELEMS * 2);
constexpr size_t WS_END = WS_SSQ + (size_t)M * 8 * 4;
constexpr int CW_PCNT = 3072;
constexpr int CW_BAR = 4096;   static_assert((4096 + 3456) * 4 <= 32768, "CTL words must fit the per-call memset");

constexpr int RING_OFF = 0, RING_BYTES = 131072;
constexpr int LDSCTL_OFF = RING_BYTES, MISC_OFF = LDSCTL_OFF + 320;
constexpr int LDS_BYTES = 147456;

#define GAS __attribute__((address_space(1)))
#define LAS __attribute__((address_space(3)))
typedef unsigned short bf16;
typedef unsigned v4u __attribute__((ext_vector_type(4)));
typedef unsigned v2u __attribute__((ext_vector_type(2)));
typedef float f32x4 __attribute__((ext_vector_type(4)));
typedef float f32x2 __attribute__((ext_vector_type(2)));
#define LDS_WAIT() asm volatile("s_waitcnt lgkmcnt(0)" ::: "memory")
#define VM_WAIT() asm volatile("s_waitcnt vmcnt(0)" ::: "memory")
__device__ __forceinline__ unsigned f2bf(float f) { unsigned u = __builtin_bit_cast(unsigned, f); return (u + 0x7fffu + ((u >> 16) & 1u)) >> 16; }
__device__ __forceinline__ unsigned pk2(float lo, float hi) { return f2bf(lo) | (f2bf(hi) << 16); }
__device__ __forceinline__ f32x4 ld4bf(const bf16* p) { const v2u w = *(const GAS v2u*)p; f32x4 r; r[0] = __builtin_bit_cast(float, w.x << 16); r[1] = __builtin_bit_cast(float, w.x & 0xffff0000u); r[2] = __builtin_bit_cast(float, w.y << 16); r[3] = __builtin_bit_cast(float, w.y & 0xffff0000u); return r; }
__device__ __forceinline__ f32x4 cvt4bf(const v2u w) { f32x4 r; r[0] = __builtin_bit_cast(float, w.x << 16); r[1] = __builtin_bit_cast(float, w.x & 0xffff0000u); r[2] = __builtin_bit_cast(float, w.y << 16); r[3] = __builtin_bit_cast(float, w.y & 0xffff0000u); return r; }
__device__ __forceinline__ float bf2f(bf16 b) { return __builtin_bit_cast(float, (unsigned)b << 16); }
__device__ __forceinline__ float fexp_(float x) { return __builtin_amdgcn_exp2f(x * 1.4426950408889634f); }
__device__ __forceinline__ float frcp_(float x) { return __builtin_amdgcn_rcpf(x); }
__device__ __forceinline__ float sigmoidf_(float x) { return frcp_(1.f + fexp_(-x)); }
__device__ __forceinline__ float siluf_(float x) { return x * frcp_(1.f + fexp_(-x)); }
__device__ __forceinline__ float softplusf_(float x) { return fmaxf(x, 0.f) + __builtin_amdgcn_logf(1.f + fexp_(-fabsf(x))) * 0.6931471805599453f; }
__device__ __forceinline__ float ftanh_(float x) { const float e = fexp_(2.f * fminf(fmaxf(x, -15.f), 15.f)); return (e - 1.f) * frcp_(e + 1.f); }

#define XB_TMO      128
#define XB_XCNT(j)  (256  + 64 * (j))
#define XB_XSUB(j)  (1280 + 64 * (j))
#define XB_XGEN(j)  (2304 + 64 * (j))
#define XB_TOP      3328
#define XB_TOPGEN   3392
#define XCD_BAR_WORDS 3456
#define XB_SPIN_CAP (1u << 21)

__device__ __forceinline__ unsigned xb_ld(unsigned* p)              { return __hip_atomic_load(p, __ATOMIC_RELAXED, __HIP_MEMORY_SCOPE_AGENT); }
__device__ __forceinline__ unsigned xb_add(unsigned* p, unsigned v) { return __hip_atomic_fetch_add(p, v, __ATOMIC_RELAXED, __HIP_MEMORY_SCOPE_AGENT); }
__device__ __forceinline__ unsigned xb_xcc_id() { return (unsigned)__builtin_amdgcn_s_getreg((3 << 11) | 20) & 0xFu; }
#define XB_SPIN(cond, bar) do { unsigned _sp = 0; while (cond) { __builtin_amdgcn_s_sleep(1); \
    if ((++_sp & 255u) == 0u) { if (xb_ld(&(bar)[XB_TMO])) break; if (_sp > XB_SPIN_CAP) { atomicAdd(&(bar)[XB_TMO], 1u); break; } } } } while (0)

struct XcdBarrier {
    unsigned* bar; unsigned x;
    volatile LAS unsigned* st;
};

__device__ __forceinline__ XcdBarrier xcd_barrier_post(unsigned* bar, volatile LAS unsigned* st, int tid) {
    XcdBarrier b; b.bar = bar; b.x = xb_xcc_id(); b.st = st;
    if (tid == 0) (void)xb_add(&bar[XB_XCNT(b.x)], 1u);
    return b;
}
__device__ __forceinline__ void xcd_barrier_complete(unsigned* bar, unsigned x, unsigned& nloc, unsigned& nx) {
    const unsigned G = gridDim.x * gridDim.y * gridDim.z;
    unsigned sum, cnt, mine, sp = 0u;
    for (;;) {
        sum = 0u; cnt = 0u; mine = 0u;
#pragma unroll
        for (unsigned j = 0; j < 16; ++j) { const unsigned c = xb_ld(&bar[XB_XCNT(j)]); sum += c; cnt += (c > 0u) ? 1u : 0u; mine = (j == x) ? c : mine; }
        if (sum == G) break;
        __builtin_amdgcn_s_sleep(1);
        if ((++sp & 255u) == 0u) { if (xb_ld(&bar[XB_TMO])) break; if (sp > XB_SPIN_CAP) { atomicAdd(&bar[XB_TMO], 1u); break; } }
    }
    nloc = mine > 0u ? mine : 1u; nx = cnt > 0u ? cnt : 1u;
}

__device__ __forceinline__ void xcd_barrier(const XcdBarrier& b, int tid) {
    asm volatile("s_waitcnt vmcnt(0)" ::: "memory");
    __syncthreads();
    if (tid == 0) {
        unsigned* bar = b.bar; asm volatile("" : "+s"(bar));
        __builtin_amdgcn_s_waitcnt(0);
        unsigned nloc = b.st[0], nx = b.st[1];
        if (nloc == 0u) { xcd_barrier_complete(bar, b.x, nloc, nx); b.st[0] = nloc; b.st[1] = nx; }
        const unsigned old = xb_add(&bar[XB_XSUB(b.x)], 1u);
        const unsigned gen = old / nloc;
        if (old + 1u == (gen + 1u) * nloc) {
            __builtin_amdgcn_fence(__ATOMIC_RELEASE, "agent");
            asm volatile("s_waitcnt vmcnt(0)" ::: "memory");
            const unsigned og = xb_add(&bar[XB_TOP], 1u);
            const unsigned tg = og / nx;
            if (og + 1u == (tg + 1u) * nx) xb_add(&bar[XB_TOPGEN], 1u);
            else XB_SPIN(xb_ld(&bar[XB_TOPGEN]) == tg, bar);
            __builtin_amdgcn_fence(__ATOMIC_ACQUIRE, "agent");
            xb_add(&bar[XB_XGEN(b.x)], 1u);
            asm volatile("s_waitcnt vmcnt(0)" ::: "memory");
        } else {
            XB_SPIN(xb_ld(&bar[XB_XGEN(b.x)]) == gen, bar);
            __builtin_amdgcn_fence(__ATOMIC_ACQUIRE, "agent");
            asm volatile("s_waitcnt vmcnt(0)" ::: "memory");
        }
    }
    __syncthreads();
}


__device__ __forceinline__ void group_barrier(unsigned* cnt, unsigned n, unsigned* tmo, int tid) {
    asm volatile("s_waitcnt vmcnt(0)" ::: "memory");
    __syncthreads();
    if (tid == 0) {
        __builtin_amdgcn_fence(__ATOMIC_RELEASE, "agent");
        asm volatile("s_waitcnt vmcnt(0)" ::: "memory");
        (void)__hip_atomic_fetch_add(cnt, 1u, __ATOMIC_RELAXED, __HIP_MEMORY_SCOPE_AGENT);
        unsigned sp = 0;
        while (__hip_atomic_load(cnt, __ATOMIC_RELAXED, __HIP_MEMORY_SCOPE_AGENT) < n) {
            __builtin_amdgcn_s_sleep(2);
            if ((++sp & 255u) == 0u) { if (__hip_atomic_load(tmo, __ATOMIC_RELAXED, __HIP_MEMORY_SCOPE_AGENT)) break; if (sp > (1u << 21)) { atomicAdd(tmo, 1u); break; } }
        }
        __builtin_amdgcn_fence(__ATOMIC_ACQUIRE, "agent");
        asm volatile("s_waitcnt vmcnt(0)" ::: "memory");
    }
    __syncthreads();
}

namespace attn_body {
using bf16=__hip_bfloat16;
using bf16x8=__attribute__((ext_vector_type(8)))short;
using s16x4=__attribute__((ext_vector_type(4)))short;
using f32x16=__attribute__((ext_vector_type(16)))float;
using u32x4=__attribute__((ext_vector_type(4)))unsigned;
constexpr int BATCH=4,NHEAD=8,SEQ=2048,D=64,DM=NHEAD*D,OPITCH=2048;
constexpr int NW=8,QBLK=32,QB=QBLK*NW,KVBLK=64,NQB=SEQ/QB;
constexpr int ATTN_PITCH=DM, ATTN_UNIT_ROWS=QB;
__device__ __forceinline__ int crow(int r,int hi){return (r&3)+8*(r>>2)+4*hi;}
#define SBAR() __builtin_amdgcn_sched_barrier(0)
__device__ __forceinline__ void cmask(f32x16&p0,f32x16&p1,int jb,int qrel,int hi){
  const float NEG=-INFINITY; int kb=64*jb+4*hi;
  #pragma unroll
  for(int r=0;r<16;++r){int kv=kb+(r&3)+8*(r>>2); if(kv>qrel)p0[r]=NEG; if(kv+32>qrel)p1[r]=NEG;}
}

constexpr int NSLOT=3, SLOTB=8192;
constexpr int LDS_K=0, LDS_V=NSLOT*SLOTB, LDS_WS=2*NSLOT*SLOTB, LDS_OST=LDS_WS+NW*64*4, LDS_BYTES=LDS_OST+NW*4096;
constexpr float C2=0.125f*1.4426950408889634f;
__device__ __forceinline__ void glds16(const void*gsrc,unsigned lds_dst){unsigned keep;
  asm volatile("s_mov_b32 %0, m0\n\ts_mov_b32 m0, %2\n\ts_nop 0\n\tglobal_load_lds_dwordx4 %1, off\n\ts_mov_b32 m0, %0":"=&s"(keep):"v"(gsrc),"s"(lds_dst):"memory");}
__device__ __forceinline__ float max3f(float a,float b,float c){float r;asm("v_max3_f32 %0, %1, %2, %3":"=v"(r):"v"(a),"v"(b),"v"(c));return r;}
__device__ __forceinline__ float max2f(float a,float b){float r;asm("v_max_f32_e32 %0, %1, %2":"=v"(r):"v"(a),"v"(b));return r;}
__device__ __forceinline__ float fadd_s(float a,float b){float r;asm("v_add_f32_e32 %0, %1, %2":"=v"(r):"v"(a),"v"(b));return r;}
__device__ __forceinline__ float fsub_s(float a,float b){float r;asm("v_sub_f32_e32 %0, %1, %2":"=v"(r):"v"(a),"v"(b));return r;}
typedef float f32x2_t __attribute__((ext_vector_type(2))); typedef __bf16 bf16x2_t __attribute__((ext_vector_type(2)));
__device__ __forceinline__ unsigned cvtpk_s(float lo,float hi){f32x2_t v={lo,hi};bf16x2_t b=__builtin_convertvector(v,bf16x2_t);return __builtin_bit_cast(unsigned,b);}
#define WAIT_BAR(N) asm volatile("s_waitcnt vmcnt(" #N ") lgkmcnt(0)\n\ts_barrier":::"memory")

__device__ __forceinline__ void qkt(f32x16&p0,f32x16&p1,const char*Kslot,const bf16x8*qr,const f32x16&negm,int r32,int hi){
  const char*kb=Kslot+hi*1024+r32*16;
  #pragma unroll
  for(int d0=0;d0<4;++d0){
    const bf16x8 b0=*reinterpret_cast<const bf16x8*>(kb+d0*2048);
    const bf16x8 b1=*reinterpret_cast<const bf16x8*>(kb+d0*2048+512);
    if(d0==0){p0=__builtin_amdgcn_mfma_f32_32x32x16_bf16(b0,qr[0],negm,0,0,0);p1=__builtin_amdgcn_mfma_f32_32x32x16_bf16(b1,qr[0],negm,0,0,0);}
    else{p0=__builtin_amdgcn_mfma_f32_32x32x16_bf16(b0,qr[d0],p0,0,0,0);p1=__builtin_amdgcn_mfma_f32_32x32x16_bf16(b1,qr[d0],p1,0,0,0);}}
}
typedef __attribute__((address_space(3))) const char* lds_cptr;
typedef short v4i16_t __attribute__((ext_vector_type(4)));
__device__ __forceinline__ void kload8(bf16x8*kf,lds_cptr kp){
  kf[0]=*(const __attribute__((address_space(3))) bf16x8*)(kp);      kf[1]=*(const __attribute__((address_space(3))) bf16x8*)(kp+512);
  kf[2]=*(const __attribute__((address_space(3))) bf16x8*)(kp+2048); kf[3]=*(const __attribute__((address_space(3))) bf16x8*)(kp+2560);
  kf[4]=*(const __attribute__((address_space(3))) bf16x8*)(kp+4096); kf[5]=*(const __attribute__((address_space(3))) bf16x8*)(kp+4608);
  kf[6]=*(const __attribute__((address_space(3))) bf16x8*)(kp+6144); kf[7]=*(const __attribute__((address_space(3))) bf16x8*)(kp+6656);
}
__device__ __forceinline__ void kload2(bf16x8*kf,lds_cptr kp,int j){ kf[2*j]=*(const __attribute__((address_space(3))) bf16x8*)(kp+j*2048); kf[2*j+1]=*(const __attribute__((address_space(3))) bf16x8*)(kp+j*2048+512); }
__device__ __forceinline__ s16x4 vtr(lds_cptr p){ return __builtin_bit_cast(s16x4,__builtin_amdgcn_ds_read_tr16_b64_v4i16((__attribute__((address_space(3))) v4i16_t*)p)); }
__device__ __forceinline__ float rowmax(const f32x16&p0,const f32x16&p1){
  float a=max3f(p0[0],p0[1],p1[0]),b=max3f(p0[2],p0[3],p1[1]);a=max3f(a,p1[2],p1[3]);
  #pragma unroll
  for(int r=4;r<16;r+=4){a=max3f(a,p0[r],p0[r+1]);b=max3f(b,p0[r+2],p0[r+3]);a=max3f(a,p1[r],p1[r+1]);b=max3f(b,p1[r+2],p1[r+3]);}
  const float m=max2f(a,b);
  auto rr=__builtin_amdgcn_permlane32_swap(__float_as_uint(m),__float_as_uint(m),false,false);
  return max2f(__uint_as_float(rr[0]),__uint_as_float(rr[1]));
}
__device__ __forceinline__ void pv(f32x16*o,int vb,bf16x8 pa0,bf16x8 pa1,bf16x8 pa2,bf16x8 pa3){
  #pragma unroll
  for(int d0=0;d0<2;++d0){s16x4 lo[4],hi[4];
    #pragma unroll
    for(int ks=0;ks<4;++ks){
      asm volatile("ds_read_b64_tr_b16 %0,%1 offset:%c2":"=&v"(lo[ks]):"v"(vb),"i"(d0*4096+ks*1024):"memory");
      asm volatile("ds_read_b64_tr_b16 %0,%1 offset:%c2":"=&v"(hi[ks]):"v"(vb),"i"(d0*4096+ks*1024+512):"memory");}
    asm volatile("s_waitcnt lgkmcnt(0)":::"memory");SBAR();
    #define PK(k) (bf16x8){lo[k][0],lo[k][1],lo[k][2],lo[k][3],hi[k][0],hi[k][1],hi[k][2],hi[k][3]}
    o[d0]=__builtin_amdgcn_mfma_f32_32x32x16_bf16(pa0,PK(0),o[d0],0,0,0);
    o[d0]=__builtin_amdgcn_mfma_f32_32x32x16_bf16(pa1,PK(1),o[d0],0,0,0);
    o[d0]=__builtin_amdgcn_mfma_f32_32x32x16_bf16(pa2,PK(2),o[d0],0,0,0);
    o[d0]=__builtin_amdgcn_mfma_f32_32x32x16_bf16(pa3,PK(3),o[d0],0,0,0);
    #undef PK
  }
}

#ifndef ATTN_STORE16
#define ATTN_STORE16(p,v) (*(u32x4*)(p)=(v))
#endif
__device__ __forceinline__ float mandf(float v,unsigned mw,int bit){ const int iv=__builtin_bit_cast(int,v); return __builtin_bit_cast(float,iv&__builtin_amdgcn_sbfe((int)mw,bit,1)); }
template<int THRL> __device__ __forceinline__ void attn_unit(int b,int h,int qb,const bf16*Q,const bf16*__restrict__ K,const bf16*__restrict__ V,bf16*O,const unsigned long long*MKb,char*shm,int tid_in){
  int tid_=tid_in; asm volatile("":"+v"(tid_)); const int tid=tid_,lane=tid&63,r32=lane&31,hi=lane>>5; const int wid=__builtin_amdgcn_readfirstlane(tid>>6);
  const long rowbase=(long)b*SEQ; const int q0=qb*QB;
  const bf16*Qw=Q+(rowbase+q0+wid*QBLK)*DM+h*D;
  const bf16*Kh=K+rowbase*DM+h*D,*Vh=V+rowbase*DM+h*D;
  const unsigned lds0=(unsigned)(uintptr_t)shm;
  float*wsf=(float*)(shm+LDS_WS)+wid*64;
  const bf16*ksrc=Kh+(long)lane*DM+wid*8;
  const bf16*vsrc=Vh+(long)(16*(wid&3)+(lane>>2))*DM+(wid>>2)*32+(lane&3)*8;
  const unsigned kdst=lds0+LDS_K+wid*1024, vdst=lds0+LDS_V+wid*1024;
  #define DMA_K(t,slot) glds16(ksrc+(long)(t)*KVBLK*DM,(unsigned)__builtin_amdgcn_readfirstlane(kdst+(slot)))
  #define DMA_V(t,slot) glds16(vsrc+(long)(t)*KVBLK*DM,(unsigned)__builtin_amdgcn_readfirstlane(vdst+(slot)))
  const int vb0=(int)(lds0+LDS_V)+((lane>>4)&1)*32+(lane&3)*8+(4*hi+((lane&15)>>2))*64;
  const char*Kbase=shm+LDS_K; bf16x8 kf[8];
  const lds_cptr shm3=(lds_cptr)shm; const lds_cptr kp0=shm3+LDS_K+hi*1024+r32*16; const lds_cptr vp0=shm3+LDS_V+((lane>>4)&1)*32+(lane&3)*8+(4*hi+((lane&15)>>2))*64;
  const int NT=(q0+QB)/KVBLK;
  const unsigned mvoff=(unsigned)(q0+wid*QBLK+r32)*8u; const int msh=4*hi;
  unsigned long long mk_c,mk_n,mk_0;
  #define MASK_LOAD(dst,tt) asm volatile("global_load_dwordx2 %0, %1, %2":"=v"(dst):"v"(mvoff),"s"(MKb+(long)(tt)*SEQ):"memory")
  #define MBIT(r) (((r)&3)+8*((r)>>2))
  #define MAND(x,mw,r) (x)=mandf((x),(mw),MBIT(r))
  MASK_LOAD(mk_0,0); MASK_LOAD(mk_c,1);
  DMA_K(0,0);DMA_V(0,0);DMA_K(1,SLOTB);
  bf16x8 qr[4];
  #pragma unroll
  for(int d0=0;d0<4;++d0)qr[d0]=*reinterpret_cast<const bf16x8*>(&Qw[(long)r32*DM+d0*16+hi*8]);
  float mhat=0.f,l_reg=0.f;f32x16 o[2];o[0]=f32x16{};o[1]=f32x16{};const f32x16 zero16=f32x16{};
  const int qrel=wid*QBLK+r32;
  #define CMASK(P0,P1,t) do{int jb_=(t)-(NT-4); if(jb_>=0)cmask(P0,P1,jb_,qrel,hi);}while(0)
  bool resc=false;
  #define START(P0,P1) do{ const float rm=rowmax(P0,P1); resc=false; \
    { const float dl=rm; mhat=fadd_s(mhat,dl); \
      _Pragma("unroll") for(int r=0;r<16;++r){P0[r]=fsub_s(P0[r],dl);P1[r]=fsub_s(P1[r],dl);} \
      } \
    _Pragma("unroll") for(int r=0;r<16;++r)P0[r]=__builtin_amdgcn_exp2f(P0[r]); }while(0)
  #define RESC() do{ if(resc){ asm volatile("s_waitcnt lgkmcnt(0)":::"memory"); \
      _Pragma("unroll") for(int d_=0;d_<2;++d_) _Pragma("unroll") for(int r=0;r<16;++r)o[d_][r]*=wsf[crow(r,hi)]; } }while(0)
  f32x16 pA0,pA1,pB0,pB1;
  int sl_prev=0,sl_cur=0,sl_next=SLOTB;
  #define ROT() do{sl_prev=sl_cur;sl_cur=sl_next;sl_next=(sl_next==(NSLOT-1)*SLOTB)?0:sl_next+SLOTB;}while(0)
  DMA_K(2,2*SLOTB);
  WAIT_BAR(3); asm volatile("":"+v"(mk_0),"+v"(mk_c));
  qkt(pA0,pA1,Kbase,qr,zero16,r32,hi);asm volatile("s_nop 15\n\ts_nop 7":"+v"(pA0),"+v"(pA1));CMASK(pA0,pA1,0);
  START(pA0,pA1);
  _Pragma("unroll") for(int r=0;r<16;++r)pA1[r]=__builtin_amdgcn_exp2f(pA1[r]);
  { const unsigned m0_=(unsigned)mk_0>>msh, m1_=(unsigned)(mk_0>>32)>>msh; _Pragma("unroll") for(int r=0;r<16;++r){ MAND(pA0[r],m0_,r); MAND(pA1[r],m1_,r);} }
  WAIT_BAR(0);
  DMA_K(3,0);DMA_V(1,SLOTB);
  ROT();
  kload8(kf,kp0+sl_cur);
  WAIT_BAR(2);
  s16x4 vlo[8],vhi[8]; u32x4 pw0,pw1,pw2,pw3;
  #define PKW(P,B) cvtpk_s(P[B],P[B+1])
  #define PAF(k) __builtin_bit_cast(bf16x8,pw##k)
  #define VFR(i) (bf16x8){vlo[i][0],vlo[i][1],vlo[i][2],vlo[i][3],vhi[i][0],vhi[i][1],vhi[i][2],vhi[i][3]}
  #define PIN(x) asm volatile("":"+v"(x))
  #define MX3(a,b,c) __builtin_fmaxf(__builtin_fmaxf((a),(b)),(c))
  #define GAPA(MF,A0,A1,A2,A3,W0,W1,PW) do{ MF; sacc+=A0; sacc+=A1; sacc+=A2; sacc+=A3; PIN(sacc); W0; W1; PIN(PW); SBAR(); }while(0)
  #define EX(v) __builtin_amdgcn_exp2f(v)
  #define GAPB(MF,X,B,MW) do{ MF; X[B]=EX(X[B]); X[B+1]=EX(X[B+1]); X[B+2]=EX(X[B+2]); X[B+3]=EX(X[B+3]); MAND(X[B],MW,B); MAND(X[B+1],MW,B+1); MAND(X[B+2],MW,B+2); MAND(X[B+3],MW,B+3); PIN(X); SBAR(); }while(0)
  #define VRD(i) do{ vlo[i]=vtr(vp_+(((i)>>2)*4096+((i)&3)*1024)); vhi[i]=vtr(vp_+(((i)>>2)*4096+((i)&3)*1024+512)); }while(0)
  #define KRD(G,j) do{ if(G){ kload2(kf,kp0+sl_next,j); SBAR(); } }while(0)
  #define STEP(C0,C1,P0,P1,t,GK,GV,GL) do{ SBAR(); \
    if((t)+1<NT){ MASK_LOAD(mk_n,(t)+1); } \
    const lds_cptr vp_=vp0+sl_prev; \
    VRD(0); SBAR(); float sacc=(P0[0]+P0[1]); \
    GAPA(C0=__builtin_amdgcn_mfma_f32_32x32x16_bf16(kf[0],qr[0],zero16,0,0,0), P0[2],P0[3],P0[4],P0[5],     pw0[0]=PKW(P0,0), pw0[1]=PKW(P0,2), pw0); \
    VRD(4); SBAR(); GAPA(C1=__builtin_amdgcn_mfma_f32_32x32x16_bf16(kf[1],qr[0],zero16,0,0,0), P0[6],P0[7],P0[8],P0[9],     pw0[2]=PKW(P0,4), pw0[3]=PKW(P0,6), pw0); \
    VRD(1); SBAR(); GAPA(C0=__builtin_amdgcn_mfma_f32_32x32x16_bf16(kf[2],qr[1],C0,0,0,0),   P0[10],P0[11],P0[12],P0[13], pw1[0]=PKW(P0,8), pw1[1]=PKW(P0,10), pw1); \
    VRD(5); SBAR(); GAPA(C1=__builtin_amdgcn_mfma_f32_32x32x16_bf16(kf[3],qr[1],C1,0,0,0),   P0[14],P0[15],P1[0],P1[1],   pw1[2]=PKW(P0,12),pw1[3]=PKW(P0,14), pw1); \
    VRD(2); SBAR(); GAPA(C0=__builtin_amdgcn_mfma_f32_32x32x16_bf16(kf[4],qr[2],C0,0,0,0),   P1[2],P1[3],P1[4],P1[5],     pw2[0]=PKW(P1,0), pw2[1]=PKW(P1,2), pw2); \
    VRD(6); SBAR(); GAPA(C1=__builtin_amdgcn_mfma_f32_32x32x16_bf16(kf[5],qr[2],C1,0,0,0),   P1[6],P1[7],P1[8],P1[9],     pw2[2]=PKW(P1,4), pw2[3]=PKW(P1,6), pw2); \
    VRD(3); SBAR(); GAPA(C0=__builtin_amdgcn_mfma_f32_32x32x16_bf16(kf[6],qr[3],C0,0,0,0),   P1[10],P1[11],P1[12],P1[13], pw3[0]=PKW(P1,8), pw3[1]=PKW(P1,10), pw3); \
    VRD(7); SBAR(); GAPA(C1=__builtin_amdgcn_mfma_f32_32x32x16_bf16(kf[7],qr[3],C1,0,0,0),   P1[14],P1[15],0.f,0.f,       pw3[2]=PKW(P1,12),pw3[3]=PKW(P1,14), pw3); \
    l_reg+=sacc; \
    if(GK){DMA_K((t)+3,sl_cur);} if(GV){DMA_V((t)+1,sl_next);} \
    _Pragma("unroll") for(int r=0;r<16;++r){C0[r]-=mhat;C1[r]-=mhat;} \
    CMASK(C0,C1,t); \
    const unsigned m0_=(unsigned)mk_c>>msh, m1_=(unsigned)(mk_c>>32)>>msh; \
    { float a=MX3(C0[0],C0[1],C1[0]),b=MX3(C0[2],C0[3],C1[1]); a=MX3(a,C1[2],C1[3]); \
      _Pragma("unroll") for(int r=4;r<16;r+=4){a=MX3(a,C0[r],C0[r+1]);b=MX3(b,C0[r+2],C0[r+3]);a=MX3(a,C1[r],C1[r+1]);b=MX3(b,C1[r+2],C1[r+3]);} \
      float rm=__builtin_fmaxf(a,b); { auto rr=__builtin_amdgcn_permlane32_swap(__float_as_uint(rm),__float_as_uint(rm),false,false); rm=__builtin_fmaxf(__uint_as_float(rr[0]),__uint_as_float(rr[1])); } \
      resc=false; \
      if(__builtin_expect(__any(rm>(float)THRL),0)){ const float dl=__builtin_fmaxf(rm,0.f); mhat+=dl; \
        _Pragma("unroll") for(int r=0;r<16;++r){C0[r]-=dl;C1[r]-=dl;} \
        const float f=__builtin_amdgcn_exp2f(-dl); l_reg*=f; if(hi==0)wsf[r32]=f; resc=true; } } \
    SBAR(); \
    GAPB(o[0]=__builtin_amdgcn_mfma_f32_32x32x16_bf16(PAF(0),VFR(0),o[0],0,0,0), C0,0,m0_); \
    GAPB(o[1]=__builtin_amdgcn_mfma_f32_32x32x16_bf16(PAF(0),VFR(4),o[1],0,0,0), C0,4,m0_); \
    KRD(GL,0); GAPB(o[0]=__builtin_amdgcn_mfma_f32_32x32x16_bf16(PAF(1),VFR(1),o[0],0,0,0), C0,8,m0_); \
    KRD(GL,1); GAPB(o[1]=__builtin_amdgcn_mfma_f32_32x32x16_bf16(PAF(1),VFR(5),o[1],0,0,0), C0,12,m0_); \
    KRD(GL,2); GAPB(o[0]=__builtin_amdgcn_mfma_f32_32x32x16_bf16(PAF(2),VFR(2),o[0],0,0,0), C1,0,m1_); \
    KRD(GL,3); GAPB(o[1]=__builtin_amdgcn_mfma_f32_32x32x16_bf16(PAF(2),VFR(6),o[1],0,0,0), C1,4,m1_); \
    GAPB(o[0]=__builtin_amdgcn_mfma_f32_32x32x16_bf16(PAF(3),VFR(3),o[0],0,0,0), C1,8,m1_); \
    GAPB(o[1]=__builtin_amdgcn_mfma_f32_32x32x16_bf16(PAF(3),VFR(7),o[1],0,0,0), C1,12,m1_); \
    }while(0)
  #define MROT() do{ asm volatile("":"+v"(mk_n)); mk_c=mk_n; }while(0)
  int t=1;
  #undef CMASK
  #define CMASK(P0,P1,t) do{}while(0)
  for(;t+5<NT;t+=2){
    STEP(pB0,pB1,pA0,pA1,t,true,true,true);     WAIT_BAR(2); MROT(); RESC(); ROT();
    STEP(pA0,pA1,pB0,pB1,t+1,true,true,true);   WAIT_BAR(2); MROT(); RESC(); ROT();
  }
  #undef CMASK
  #define CMASK(P0,P1,t) do{int jb_=(t)-(NT-4); if(jb_>=0)cmask(P0,P1,jb_,qrel,hi);}while(0)
  #define ENDW(tt) do{ if((tt)+3<NT){WAIT_BAR(2);} else if((tt)+2<NT){WAIT_BAR(1);} else {WAIT_BAR(0);} }while(0)
  for(;t+1<NT;t+=2){
    STEP(pB0,pB1,pA0,pA1,t,(t+3<NT),(t+1<NT),(t+1<NT));       ENDW(t);   MROT(); RESC(); ROT();
    STEP(pA0,pA1,pB0,pB1,t+1,(t+4<NT),(t+2<NT),(t+2<NT));     ENDW(t+1); MROT(); RESC(); ROT();
  }
  STEP(pB0,pB1,pA0,pA1,NT-1,false,false,false); RESC();
  { float sacc=pB0[0]+pB0[1]; _Pragma("unroll") for(int r=2;r<16;++r)sacc+=pB0[r]; _Pragma("unroll") for(int r=0;r<16;++r)sacc+=pB1[r]; l_reg+=sacc;
    pw0=(u32x4){PKW(pB0,0),PKW(pB0,2),PKW(pB0,4),PKW(pB0,6)};pw1=(u32x4){PKW(pB0,8),PKW(pB0,10),PKW(pB0,12),PKW(pB0,14)};pw2=(u32x4){PKW(pB1,0),PKW(pB1,2),PKW(pB1,4),PKW(pB1,6)};pw3=(u32x4){PKW(pB1,8),PKW(pB1,10),PKW(pB1,12),PKW(pB1,14)};
    SBAR(); pv(o,vb0+sl_cur,PAF(0),PAF(1),PAF(2),PAF(3)); }
  #undef PKW
  #undef PAF
  #undef VFR
  #undef PIN
  #undef MX3
  #undef GAPA
  #undef GAPB
  #undef EX
  #undef VRD
  #undef KRD
  #undef STEP
  #undef ENDW
  {auto rr=__builtin_amdgcn_permlane32_swap(__float_as_uint(l_reg),__float_as_uint(l_reg),false,false);l_reg=__uint_as_float(rr[0])+__uint_as_float(rr[1]);}
  if(hi==0)wsf[32+r32]=l_reg;asm volatile("s_waitcnt lgkmcnt(0)":::"memory");
  float rli[16];
  #pragma unroll
  for(int r=0;r<16;++r)rli[r]=__builtin_amdgcn_rcpf(wsf[32+crow(r,hi)]);
  bf16*Ow=O+(rowbase+q0+wid*QBLK)*OPITCH+h*D;
  { bf16*stg=(bf16*)(shm+LDS_OST)+wid*2048;
    #pragma unroll
    for(int r=0;r<16;++r){const int orow=crow(r,hi);
      #pragma unroll
      for(int d0=0;d0<2;++d0)stg[orow*64+d0*32+r32]=__float2bfloat16(o[d0][r]*rli[r]);}
    asm volatile("s_waitcnt lgkmcnt(0)":::"memory");
    #pragma unroll
    for(int i=0;i<4;++i){const int row=i*8+(lane>>3),ch=lane&7; const u32x4 v=*(const u32x4*)(stg+row*64+ch*8); ATTN_STORE16(Ow+(long)row*OPITCH+ch*8,v);} }
  asm volatile("s_waitcnt lgkmcnt(0)\n\ts_barrier":::"memory");
  #undef DMA_K
  #undef DMA_V
  #undef MASK_LOAD
  #undef MBIT
  #undef MAND
  #undef MROT
  #undef CMASK
  #undef START
  #undef RESC
  #undef ROT
}
constexpr int ATTN_LDS_BYTES=LDS_BYTES;
struct AttnTensors { const bf16* Q; const bf16* K; const bf16* V; bf16* O; const unsigned long long* MK; };
#undef SBAR
#undef WAIT_BAR
}

struct Args { const void* in[32]; float* out; unsigned char* ws; int ph_lo, ph_hi; };
struct Frame {
    LAS unsigned char* lds; char* ldsg; volatile LAS unsigned* MISC; unsigned* ctl;
    int tid, lane, wave, vcu, G;
};
template <int CTRL> __device__ __forceinline__ float dpp_f(float x) { return __builtin_bit_cast(float, __builtin_amdgcn_update_dpp(0, __builtin_bit_cast(int, x), CTRL, 0xf, 0xf, true)); }
template <int CTRL> __device__ __forceinline__ int dpp_i(int x) { return __builtin_amdgcn_update_dpp(0, x, CTRL, 0xf, 0xf, true); }
__device__ __forceinline__ float rdlane_f(float x, int l) { return __builtin_bit_cast(float, __builtin_amdgcn_readlane(__builtin_bit_cast(int, x), l)); }
__device__ __forceinline__ float swz16_f(float x) { return __builtin_bit_cast(float, __builtin_amdgcn_ds_swizzle(__builtin_bit_cast(int, x), 0x401F)); }
__device__ __forceinline__ int swz16_i(int x) { return __builtin_amdgcn_ds_swizzle(x, 0x401F); }
__device__ __forceinline__ float row16_sum(float x) {
    x += dpp_f<0xB1>(x);
    x += dpp_f<0x4E>(x);
    x += dpp_f<0x141>(x);
    x += dpp_f<0x140>(x);
    return x;
}
__device__ __forceinline__ float wave_sum(float v) {
    v = row16_sum(v); v += swz16_f(v);
    return __builtin_bit_cast(float, __builtin_amdgcn_readlane(__builtin_bit_cast(int, v), 0)) + __builtin_bit_cast(float, __builtin_amdgcn_readlane(__builtin_bit_cast(int, v), 32));
}
__device__ __forceinline__ void transpose_item(const float* W, int K, int N, bf16* WT, int k0, int n0, int dst_row0, LAS float* scr, int lane) {
    const int nn = n0 + (lane & 31); const bool ok = nn < N;
    const GAS float* src = (const GAS float*)(W + (size_t)(k0 + (lane >> 5)) * N + nn);
    float t[32];
#pragma unroll
    for (int i = 0; i < 32; ++i) t[i] = ok ? src[(size_t)(2 * i) * N] : 0.f;
#pragma unroll
    for (int i = 0; i < 32; ++i) scr[(2 * i + (lane >> 5)) * 33 + (lane & 31)] = t[i];
    LDS_WAIT(); asm volatile("" ::: "memory");
    const int c = lane & 7;
#pragma unroll
    for (int j = 0; j < 4; ++j) { const int n = (lane >> 3) + 8 * j; const LAS float* sp = scr + (8 * c) * 33 + n;
        v4u o; o.x = pk2(sp[0 * 33], sp[1 * 33]); o.y = pk2(sp[2 * 33], sp[3 * 33]); o.z = pk2(sp[4 * 33], sp[5 * 33]); o.w = pk2(sp[6 * 33], sp[7 * 33]);
        *(GAS v4u*)(WT + (size_t)(dst_row0 + n) * K + k0 + 8 * c) = o; }
    LDS_WAIT(); asm volatile("" ::: "memory");
}
__device__ inline void sincos_d(double x, double& s, double& c) {
    const double k = rint(x * 0.63661977236758134308);
    double r = x - k * 1.57079632679489655800e+00; r -= k * 6.12323399573676603587e-17;
    const double r2 = r * r;
    double sp = r * (1.0 + r2 * (-1.0 / 6 + r2 * (1.0 / 120 + r2 * (-1.0 / 5040 + r2 * (1.0 / 362880 + r2 * (-1.0 / 39916800 + r2 * (1.0 / 6227020800.0)))))));
    double cp = 1.0 + r2 * (-0.5 + r2 * (1.0 / 24 + r2 * (-1.0 / 720 + r2 * (1.0 / 40320 + r2 * (-1.0 / 3628800 + r2 * (1.0 / 479001600.0 + r2 * (-1.0 / 87178291200.0)))))));
    const long long q = (long long)k; const int m = (int)(((q % 4) + 4) % 4);
    if (m == 0) { s = sp; c = cp; } else if (m == 1) { s = cp; c = -sp; } else if (m == 2) { s = -sp; c = -cp; } else { s = -cp; c = sp; }
}

constexpr int CV_GU = (D / 64) * (FF / 32);
constexpr int CV_D = (FF / 64) * (D / 32);
constexpr int CV_IN = (D / 64) * (DINP / 32);
constexpr int CV_OUT = (D / 64) * (D / 32);
constexpr int CV_PER_L = 2 * (2 * CV_GU + CV_D) + CV_IN + CV_OUT;
__device__ __forceinline__ void convert_item(const Args& a, unsigned char* ws, int it, LAS float* scr, int lane) {
    const int l = it / CV_PER_L; int r = it % CV_PER_L;
    if (r < 2 * (2 * CV_GU + CV_D)) {
        const int f = r / (2 * CV_GU + CV_D); r %= (2 * CV_GU + CV_D);
        const size_t lf = (size_t)l * 2 + f;
        if (r < 2 * CV_GU) {
            const int s = r / CV_GU; r %= CV_GU;
            const float* W = (const float*)a.in[6 + s] + lf * (size_t)D * FF;
            const int kb = r / (FF / 32), nb = r % (FF / 32), n0 = nb * 32;
            transpose_item(W, D, FF, (bf16*)(ws + WS_WGU + lf * SZ_WGU), kb * 64, n0, 256 * (n0 >> 7) + 128 * s + (n0 & 127), scr, lane);
        } else {
            r -= 2 * CV_GU;
            const float* W = (const float*)a.in[8] + lf * (size_t)FF * D;
            const int kb = r / (D / 32), nb = r % (D / 32);
            transpose_item(W, FF, D, (bf16*)(ws + WS_WD + lf * SZ_WD), kb * 64, nb * 32, nb * 32, scr, lane);
        }
    } else {
        r -= 2 * (2 * CV_GU + CV_D);
        if (r < CV_IN) {
            const float* W = (const float*)a.in[9] + (size_t)l * D * DIN;
            const int kb = r / (DINP / 32), nb = r % (DINP / 32);
            transpose_item(W, D, DIN, (bf16*)(ws + WS_WIN + (size_t)l * SZ_WIN), kb * 64, nb * 32, nb * 32, scr, lane);
        } else {
            r -= CV_IN;
            const float* W = (const float*)a.in[10] + (size_t)l * D * D;
            const int kb = r / (D / 32), nb = r % (D / 32);
            transpose_item(W, D, D, (bf16*)(ws + WS_WOUT + (size_t)l * SZ_WOUT), kb * 64, nb * 32, nb * 32, scr, lane);
        }
    }
}
constexpr int CV_F = 2 * CV_GU + CV_D, CV_IO = CV_IN + CV_OUT, CV_ABC = CV_D + CV_OUT + CV_F + CV_IO + 2 * CV_GU, CV_SLOT = (CV_ABC + 2) / 3;
static_assert(CV_SLOT >= CV_D + CV_OUT && 2 * CV_SLOT >= CV_D + CV_OUT + CV_F, "layer 0's second down projection and the first FFN of layer 1 must be complete after slot 1");
__device__ __forceinline__ int deferred_item(int d) {
    if (d < CV_OUT) return 2 * CV_F + CV_IN + d;
    d -= CV_OUT;
    if (d < CV_D) return CV_F + 2 * CV_GU + d;
    d -= CV_D;
    if (d < CV_F) return CV_PER_L + d;
    if (d < CV_F + CV_IO) return CV_PER_L + 2 * CV_F + (d - CV_F);
    return CV_PER_L + CV_F + (d - CV_F - CV_IO);
}
__device__ __forceinline__ void convert_slot(Frame& F, const Args& a, unsigned char* ws, int slot, int bid) {
    LAS float* scr = (LAS float*)(F.lds + F.wave * 16384);
    int lane = F.lane; asm volatile("" : "+v"(lane));
    const int gw = (bid - 128) * NWAVES + F.wave;
    if (slot < 3) { const int d1 = (slot + 1) * CV_SLOT < CV_ABC ? (slot + 1) * CV_SLOT : CV_ABC;
        for (int d = slot * CV_SLOT + gw; d < d1; d += 128 * NWAVES) convert_item(a, ws, deferred_item(d), scr, lane); }
    else for (int d = gw; d < CV_D; d += 128 * NWAVES) convert_item(a, ws, CV_PER_L + CV_F + 2 * CV_GU + d, scr, lane);
}

__device__ __forceinline__ void p0_prologue(Frame& F, const Args& a) {
    unsigned char* ws = a.ws;
    {
        const float* c = (const float*)a.in[1]; const float* ada_w = (const float*)a.in[3]; const float* ada_b = (const float*)a.in[4];
        float* MOD = (float*)(ws + WS_MOD);
        LAS float* cond = (LAS float*)(F.lds);
        LAS float* red = (LAS float*)(F.lds + 32768);
        for (int i = F.tid; i < 4 * 2048; i += NTHR) { const int b = i >> 11, k = i & 2047; cond[k * 4 + b] = siluf_(c[i]); }
        __syncthreads();
        for (int it = blockIdx.x; it < 256; it += F.G) {
            const int l = it >> 7, n0 = (it & 127) * 144;
            const bool act = F.lane < 36;
            const float* w = ada_w + (size_t)l * D * NMODC + n0 + 4 * (act ? F.lane : 0);
            f32x4 acc[4] = {};
            const int kb = F.wave * 256;
            if (act) {
#pragma unroll 16
                for (int k = kb; k < kb + 256; ++k) { const f32x4 wv = *(const GAS f32x4*)(w + (size_t)k * NMODC); const f32x4 cv = *(const LAS f32x4*)(cond + k * 4);
#pragma unroll
                    for (int b = 0; b < 4; ++b) acc[b] += wv * cv[b]; }
#pragma unroll
                for (int b = 0; b < 4; ++b) *(LAS f32x4*)(red + (F.wave * 4 + b) * 144 + 4 * F.lane) = acc[b];
            }
            __syncthreads();
            for (int o = F.tid; o < 4 * 144; o += NTHR) { const int b = o / 144, n = o - b * 144; float s = ada_b[l * NMODC + n0 + n];
#pragma unroll
                for (int w8 = 0; w8 < 8; ++w8) s += red[(w8 * 4 + b) * 144 + n];
                MOD[((size_t)l * 4 + b) * NMODC + n0 + n] = s; }
            __syncthreads();
        }
    }
    {
        const int* pos = (const int*)a.in[2]; float* rc = (float*)(ws + WS_ROPC); float* rs = (float*)(ws + WS_ROPS);
        for (int gid = blockIdx.x * NTHR + F.tid; gid < M * 32; gid += F.G * NTHR) {
            const int m = gid >> 5, i = gid & 31;
            const float inv = (float)pow(10000.0, -(double)i / 32.0);
            const float ang = (float)pos[m] * inv;
            double s, c; sincos_d((double)ang, s, c);
            rc[gid] = (float)c; rs[gid] = (float)s;
        }
    }
    {
        for (int gid = blockIdx.x * NTHR + F.tid; gid < 2 * (int)LW_ELEMS; gid += F.G * NTHR) {
            const int l = gid / (int)LW_ELEMS; int e = gid % (int)LW_ELEMS; float v;
            if (e < (int)LW_A2) { const int n = e / 64, k = e % 64; v = ((const float*)a.in[13])[(size_t)l * 64 * RW + k * RW + n]; }
            else if (e < (int)LW_G2) { e -= LW_A2; const int n = e / 64, k = e % 64; v = ((const float*)a.in[15])[(size_t)l * 64 * RW + k * RW + n]; }
            else if (e < (int)LW_V1) { e -= LW_G2; const int n = e / 128, k = e % 128; v = ((const float*)a.in[16])[(size_t)l * 128 * RW + k * RW + n]; }
            else if (e < (int)LW_V2) { e -= LW_V1; const int n = e / 768, k = e % 768; v = ((const float*)a.in[23])[k * 32 + n]; }
            else { e -= LW_V2; const int n = e / 32, k = e % 32; v = ((const float*)a.in[24])[k * RW + n]; }
            ((bf16*)(ws + WS_LW))[gid] = (bf16)f2bf(v);
        }
    }
    {
        __syncthreads();
        LAS float* scr = (LAS float*)(F.lds + F.wave * 16384);
        const int gw = F.vcu * NWAVES + F.wave, NGW = F.G * NWAVES;
        for (int j = gw; j < CV_PER_L - CV_D - CV_OUT; j += NGW) convert_item(a, ws, j < CV_F + 2 * CV_GU ? j : j + CV_D, scr, F.lane);
    }
}

namespace pg8 {
template <bool FINAL, bool BASEF32> struct EpiResidNormT {
    static constexpr bool PERM = true, AFTER_DRAIN = true;
    const void* base; void* out; int ldc; const float* gate; float coef;
    const float* nw; const float* shift; const float* scale; bf16_t* Hn; float* ssq; unsigned* pcnt; unsigned* tmo;
    __device__ __forceinline__ void fused(f32x4 (&acc)[2][2][4][2], const Unit& u, int wr, int wc, int fr, int fq, LAS unsigned char* lds, int wid, int lane) const {
        const int tid = wid * 64 + lane;
        const int rowl0 = wr * 64 + fr, row0 = u.pm * BM + rowl0, col0 = u.pn * BM + wc * 32 + 8 * fq, b = u.pm >> 3;
        const float* gp = gate + (size_t)b * NMODC + col0;
        f32x4 gv[2][2], nwv[2][2], sc1[2][2], sh[2][2];
#pragma unroll
        for (int bj = 0; bj < 2; ++bj)
#pragma unroll
            for (int n = 0; n < 2; ++n) gv[bj][n] = *(const f32x4*)(gp + bj * HALF + n * 4) * coef;
        float p[8];
#pragma unroll
        for (int g = 0; g < 8; ++g) { const int ai = g >> 2, m = g & 3; const size_t off = (size_t)(row0 + ai * HALF + m * 16) * ldc + col0;
            float sq = 0.f;
#pragma unroll
            for (int bj = 0; bj < 2; ++bj)
                { f32x4 b0, b1;
                  if constexpr (BASEF32) { b0 = *(const f32x4*)((const float*)base + off + bj * HALF); b1 = *(const f32x4*)((const float*)base + off + bj * HALF + 4); }
                  else { const u32x4 rw = *(const u32x4*)((const bf16_t*)base + off + bj * HALF);
                      b0.x = __builtin_bit_cast(float, rw.x << 16); b0.y = __builtin_bit_cast(float, rw.x & 0xffff0000u); b0.z = __builtin_bit_cast(float, rw.y << 16); b0.w = __builtin_bit_cast(float, rw.y & 0xffff0000u);
                      b1.x = __builtin_bit_cast(float, rw.z << 16); b1.y = __builtin_bit_cast(float, rw.z & 0xffff0000u); b1.z = __builtin_bit_cast(float, rw.w << 16); b1.w = __builtin_bit_cast(float, rw.w & 0xffff0000u); }
                  const f32x4 x0 = b0 + acc[ai][bj][m][0] * gv[bj][0], x1 = b1 + acc[ai][bj][m][1] * gv[bj][1]; acc[ai][bj][m][0] = x0; acc[ai][bj][m][1] = x1;
                  sq += ((x0.x * x0.x + x0.y * x0.y) + (x0.z * x0.z + x0.w * x0.w)) + ((x1.x * x1.x + x1.y * x1.y) + (x1.z * x1.z + x1.w * x1.w)); }
            sq += swz16_f(sq);
            { auto rr = __builtin_amdgcn_permlane32_swap(__builtin_bit_cast(unsigned, sq), __builtin_bit_cast(unsigned, sq), false, false); const unsigned r0_ = rr[0], r1_ = rr[1]; sq = __builtin_bit_cast(float, r0_) + __builtin_bit_cast(float, r1_); }
            p[g] = sq;
            if (g & 1) asm volatile("" ::: "memory"); }
        LAS float* red = (LAS float*)lds;
        if (fq == 0) {
#pragma unroll
            for (int g = 0; g < 8; ++g) red[wc * 256 + (g >> 2) * HALF + rowl0 + (g & 3) * 16] = p[g]; }
        __syncthreads();
        float* srow = ssq + ((size_t)u.pm * 256 + (tid & 255)) * 8;
        if (tid < 256) __hip_atomic_store(srow + u.pn, (red[tid] + red[256 + tid]) + (red[512 + tid] + red[768 + tid]), __ATOMIC_RELAXED, __HIP_MEMORY_SCOPE_AGENT);
        asm volatile("s_waitcnt vmcnt(0)" ::: "memory");
        __syncthreads();
        if (tid == 0) (void)__hip_atomic_fetch_add(pcnt + u.pm, 1u, __ATOMIC_RELAXED, __HIP_MEMORY_SCOPE_AGENT);
        if constexpr (!FINAL) {
#pragma unroll
            for (int g = 0; g < 8; ++g) { const int ai = g >> 2, m = g & 3; const size_t off = (size_t)(row0 + ai * HALF + m * 16) * ldc + col0;
#pragma unroll
                for (int bj = 0; bj < 2; ++bj) { const f32x4 x0 = acc[ai][bj][m][0], x1 = acc[ai][bj][m][1];
                    u32x4 w; w.x = pk2(x0.x, x0.y); w.y = pk2(x0.z, x0.w); w.z = pk2(x1.x, x1.y); w.w = pk2(x1.z, x1.w); *(u32x4*)((bf16_t*)out + off + bj * HALF) = w; } } }
#pragma unroll
        for (int bj = 0; bj < 2; ++bj)
#pragma unroll
            for (int n = 0; n < 2; ++n) { const int cc = col0 + bj * HALF + n * 4; nwv[bj][n] = *(const f32x4*)(nw + cc);
                if constexpr (!FINAL) { sc1[bj][n] = *(const f32x4*)(scale + (size_t)b * NMODC + cc) + 1.0f; sh[bj][n] = *(const f32x4*)(shift + (size_t)b * NMODC + cc); } }
        if (tid == 0) { unsigned sp = 0;
            while (__hip_atomic_load(pcnt + u.pm, __ATOMIC_RELAXED, __HIP_MEMORY_SCOPE_AGENT) < 8u) { __builtin_amdgcn_s_sleep(1);
                if ((++sp & 255u) == 0u) { if (__hip_atomic_load(tmo, __ATOMIC_RELAXED, __HIP_MEMORY_SCOPE_AGENT)) break; if (sp > (1u << 21)) { atomicAdd(tmo, 1u); break; } } } }
        __syncthreads();
        if (tid < 256) { float t8[8];
#pragma unroll
            for (int j = 0; j < 8; ++j) t8[j] = __hip_atomic_load(srow + j, __ATOMIC_RELAXED, __HIP_MEMORY_SCOPE_AGENT);
            red[1024 + tid] = 1.0f / sqrtf((((t8[0] + t8[1]) + (t8[2] + t8[3])) + ((t8[4] + t8[5]) + (t8[6] + t8[7]))) * (1.f / D) + NORM_EPS); }
        __syncthreads();
#pragma unroll
        for (int g = 0; g < 8; ++g) { const int ai = g >> 2, m = g & 3; const float rstd = red[1024 + ai * HALF + rowl0 + m * 16];
#pragma unroll
            for (int bj = 0; bj < 2; ++bj)
                if constexpr (FINAL) { float* op = (float*)out + (size_t)(row0 + ai * HALF + m * 16) * ldc + col0 + bj * HALF; *(f32x4*)op = acc[ai][bj][m][0] * rstd * nwv[bj][0]; *(f32x4*)(op + 4) = acc[ai][bj][m][1] * rstd * nwv[bj][1]; }
                else { bf16_t* rowp = Hn + (size_t)(row0 + ai * HALF + m * 16) * ldc + col0;
                    f32x4 y0 = acc[ai][bj][m][0] * rstd * nwv[bj][0]; y0 = y0 * sc1[bj][0] + sh[bj][0]; f32x4 y1 = acc[ai][bj][m][1] * rstd * nwv[bj][1]; y1 = y1 * sc1[bj][1] + sh[bj][1];
                    u32x4 w; w.x = pk2(y0.x, y0.y); w.y = pk2(y0.z, y0.w); w.z = pk2(y1.x, y1.y); w.w = pk2(y1.z, y1.w); *(u32x4*)(rowp + bj * HALF) = w; } }
        __syncthreads();
    }
};

}
__device__ __forceinline__ void norm_mod_phase(Frame& F, const float* x, const float* g, const float* shift, const float* scale, bf16* h) {
    const int gw = F.vcu * NWAVES + F.wave, NGW = F.G * NWAVES;
    int lane = F.lane; asm volatile("" : "+v"(lane));
#pragma unroll 1
    for (int m = gw; m < M; m += NGW) {
        const int b = m >> 11;
        const GAS f32x4* xr = (const GAS f32x4*)(x + (size_t)m * D) + lane;
        const GAS f32x4* gp = (const GAS f32x4*)g + lane; const GAS f32x4* shp = (const GAS f32x4*)(shift + (size_t)b * NMODC) + lane; const GAS f32x4* scp = (const GAS f32x4*)(scale + (size_t)b * NMODC) + lane;
        f32x4 v[8], gv[8], sh[8], sc[8]; float s = 0.f;
#pragma unroll
        for (int j = 0; j < 8; ++j) v[j] = xr[64 * j];
#pragma unroll
        for (int j = 0; j < 8; ++j) { gv[j] = gp[64 * j]; sh[j] = shp[64 * j]; sc[j] = scp[64 * j]; }
#pragma unroll
        for (int j = 0; j < 8; ++j) s += (v[j].x * v[j].x + v[j].y * v[j].y) + (v[j].z * v[j].z + v[j].w * v[j].w);
        const float rstd = 1.0f / sqrtf(wave_sum(s) * (1.f / D) + NORM_EPS);
        GAS v2u* o8 = (GAS v2u*)(h + (size_t)m * D) + lane;
#pragma unroll
        for (int j = 0; j < 8; ++j) {
            f32x4 y = v[j] * rstd * gv[j]; y = y * (sc[j] + 1.0f) + sh[j];
            v2u w; w.x = pk2(y.x, y.y); w.y = pk2(y.z, y.w); o8[64 * j] = w;
        }
    }
}
__device__ __forceinline__ void final_norm_phase(Frame& F, const float* x, const float* g, float* out) {
    const int gw = F.vcu * NWAVES + F.wave, NGW = F.G * NWAVES;
    for (int m = gw; m < M; m += NGW) {
        const GAS f32x4* xr = (const GAS f32x4*)(x + (size_t)m * D) + F.lane;
        f32x4 v[8]; float s = 0.f;
#pragma unroll
        for (int j = 0; j < 8; ++j) { v[j] = xr[64 * j]; s += (v[j].x * v[j].x + v[j].y * v[j].y) + (v[j].z * v[j].z + v[j].w * v[j].w); }
        const float rstd = 1.0f / sqrtf(wave_sum(s) * (1.f / D) + NORM_EPS);
        GAS f32x4* o = (GAS f32x4*)(out + (size_t)m * D) + F.lane;
#pragma unroll
        for (int j = 0; j < 8; ++j) { const f32x4 gv = *(const f32x4*)(g + 4 * F.lane + 256 * j); o[64 * j] = v[j] * rstd * gv; }
    }
}

struct MixW {
    const float *mu, *w0, *w2, *a0, *a2, *g2, *k_k, *k_a, *r_k, *ln_w, *ln_b, *v0, *v1, *v2, *conv_w, *conv_b, *dt_bias, *a_log, *d_skip, *norm_w;
    int layer;
};
constexpr float ATT_C2 = 0.125f * 1.4426950408889634f;
__device__ __forceinline__ void attn_prep_tok(Frame& F, int m, const float* u, const float* rc, const float* rs, bf16* Q, bf16* Kb, bf16* Vb, bf16* IQ, bf16* IK, float* IW) {
    const float* ur = u + (size_t)m * DINP; const float* c = rc + (size_t)m * 32; const float* s = rs + (size_t)m * 32;
    int tid0 = F.tid; asm volatile("" : "+v"(tid0));
    for (int i = tid0; i < 33 * 32; i += NTHR) {
        const int hh = i >> 5, j = i & 31;
        const float* src; bf16* dst; float sc = 1.f;
        if (hh < 8) { src = ur + U_Q + hh * 64; dst = Q + (size_t)m * AW + hh * 64; sc = ATT_C2; }
        else if (hh < 16) { src = ur + U_K + (hh - 8) * 64; dst = Kb + (size_t)m * AW + (hh - 8) * 64; }
        else if (hh < 32) { src = ur + U_IQ + (hh - 16) * 64; dst = IQ + (size_t)m * 1024 + (hh - 16) * 64; }
        else { src = ur + U_IK; dst = IK + (size_t)m * 64; }
        const float x1 = src[j], x2 = src[j + 32];
        dst[j] = (bf16)f2bf((x1 * c[j] - x2 * s[j]) * sc); dst[j + 32] = (bf16)f2bf((x2 * c[j] + x1 * s[j]) * sc);
    }
    { const int i = tid0; Vb[(size_t)m * AW + i] = (bf16)f2bf(ur[U_V + i]); }
    if (tid0 < 16) IW[(size_t)m * 16 + tid0] = ur[U_IW + tid0] * (0.25f * 0.125f);
}
__device__ __forceinline__ void rwkv_prep_tok(Frame& F, int m, const float* u, const MixW& w, float* vfirst, float* R, float* Wd, float* K, float* V, float* A, float* Bv, float* G) {
    const int t = m & (T - 1); int tid = F.tid; asm volatile("" : "+v"(tid));
    LAS float* xs = (LAS float*)F.lds;
    LAS float* t32 = xs + RC;
    LAS float* av = t32 + 32;
    LAS float* kkv = av + RW;
    LAS float* hn = kkv + RW;
    LAS float* act = hn + 16;
    const float* ur = u + (size_t)m * DINP + U_RW;
    for (int c = tid; c < RC; c += NTHR) { const float cur = ur[c]; const float prev = (t > 0) ? ur[c - DINP] : 0.f; xs[c] = cur + (prev - cur) * w.mu[c]; }
    __syncthreads();
    LAS float* xr = xs; LAS float* xk = xs + 768; LAS float* xv = xs + 1536; LAS float* wl = xs + 2304; LAS float* al = xs + 2368; LAS float* gl = xs + 2432;
    if (tid < 64) act[tid] = tanhf(wl[tid]); else if (tid < 128) act[tid] = al[tid - 64]; else if (tid < 256) act[tid] = sigmoidf_(gl[tid - 128]);
    LAS float* t32p = act + 256;
    if (w.layer > 0) { const int q = tid & 31, part = tid >> 5; float s = 0.f; for (int c = part * 48; c < part * 48 + 48; ++c) s += xv[c] * w.v1[c * 32 + q]; t32p[part * 32 + q] = s; }
    __syncthreads();
    if (w.layer > 0 && tid < 32) { float s = 0.f;
#pragma unroll
        for (int pp = 0; pp < 16; ++pp) s += t32p[pp * 32 + tid]; t32[tid] = s; }
    __syncthreads();
    for (int c = tid; c < RW; c += NTHR) {
        float sw = w.w0[c], sa = w.a0[c], sg = 0.f;
        for (int j = 0; j < 64; ++j) { sw += act[j] * w.w2[j * RW + c]; sa += act[64 + j] * w.a2[j * RW + c]; }
        for (int j = 0; j < 128; ++j) sg += act[128 + j] * w.g2[j * RW + c];
        const float w_log = -softplusf_(-sw) - 0.5f;
        const float decay = expf(-expf(w_log));
        const float a = sigmoidf_(sa);
        float v = xv[c];
        if (w.layer == 0) vfirst[(size_t)m * RW + c] = v;
        else { float s = w.v0[c]; for (int j = 0; j < 32; ++j) s += t32[j] * w.v2[j * RW + c]; v = v + (vfirst[(size_t)m * RW + c] - v) * sigmoidf_(s); }
        av[c] = a; kkv[c] = xk[c] * w.k_k[c];
        R[(size_t)m * RW + c] = xr[c]; Wd[(size_t)m * RW + c] = decay; V[(size_t)m * RW + c] = v; G[(size_t)m * RW + c] = sg;
        K[(size_t)m * RW + c] = xk[c] * (1.f + (a - 1.f) * w.k_a[c]);
    }
    __syncthreads();
    { const int lane_ = tid & 63, wv_ = F.wave;
      for (int hh = wv_; hh < RH; hh += NWAVES) { const float q = kkv[hh * 64 + lane_]; const float ss = wave_sum(q * q); if (lane_ == 0) hn[hh] = fmaxf(sqrtf(ss), 1e-12f); } }
    __syncthreads();
    for (int c = tid; c < RW; c += NTHR) { const float kk = kkv[c] / hn[c >> 6]; A[(size_t)m * RW + c] = -kk; Bv[(size_t)m * RW + c] = kk * av[c]; }
    __syncthreads();
}
__device__ __forceinline__ void ssm_prep_tok(Frame& F, int m, const float* u, const MixW& w, float* XBC, float* DT, bf16* sB, bf16* sC) {
    const int t = m & (T - 1); int tid = F.tid; asm volatile("" : "+v"(tid));
    for (int c = tid; c < SCD; c += NTHR) {
        float y = w.conv_b[c];
#pragma unroll
        for (int j = 0; j < 4; ++j) { const int tt = t - 3 + j; if (tt >= 0) y += w.conv_w[c * 4 + j] * u[(size_t)(m - 3 + j) * DINP + U_XBC + c]; }
        const float sv = siluf_(y);
        XBC[(size_t)m * SCD + c] = sv;
        if (c >= 1280) sC[(size_t)m * 512 + (c - 1280)] = (bf16)f2bf(sv); else if (c >= 768) sB[(size_t)m * 512 + (c - 768)] = (bf16)f2bf(sv);
    }
    if (tid < SH) DT[(size_t)m * SH + tid] = softplusf_(u[(size_t)m * DINP + U_DT + tid] + w.dt_bias[tid]);
}
typedef short bf16x8v __attribute__((ext_vector_type(8)));
typedef float f32x16 __attribute__((ext_vector_type(16)));
__device__ __forceinline__ int half32_sum_i(int x) { x += dpp_i<0xB1>(x); x += dpp_i<0x4E>(x); x += dpp_i<0x141>(x); x += dpp_i<0x140>(x); x += swz16_i(x); return x; }
__device__ __forceinline__ float half32_min_f(float x) { x = fminf(x, dpp_f<0xB1>(x)); x = fminf(x, dpp_f<0x4E>(x)); x = fminf(x, dpp_f<0x141>(x)); x = fminf(x, dpp_f<0x140>(x)); x = fminf(x, swz16_f(x)); return x; }
__device__ __forceinline__ float half32_max_f(float x) { x = fmaxf(x, dpp_f<0xB1>(x)); x = fmaxf(x, dpp_f<0x4E>(x)); x = fmaxf(x, dpp_f<0x141>(x)); x = fmaxf(x, dpp_f<0x140>(x)); x = fmaxf(x, swz16_f(x)); return x; }
template <int LN> __device__ __forceinline__ void wlane(unsigned& x, unsigned v) { asm volatile("s_nop 1\n\tv_writelane_b32 %0, %1, %2" : "+v"(x) : "s"(v), "n"(LN)); }
template <int I> struct MaskBuild {
    static __device__ __forceinline__ void run(const float (&sc)[64], float thr, unsigned& X, unsigned& Y, unsigned& Z, unsigned& Wd) {
        const unsigned long long bal = __builtin_amdgcn_ballot_w64(sc[I] >= thr);
        const unsigned blo = (unsigned)bal, bhi = (unsigned)(bal >> 32);
        if ((I & 1) == 0) { wlane<(I >> 1)>(X, blo); wlane<(I >> 1)>(Z, bhi); } else { wlane<(I >> 1)>(Y, blo); wlane<(I >> 1)>(Wd, bhi); }
        MaskBuild<I + 1>::run(sc, thr, X, Y, Z, Wd);
    }
};
template <> struct MaskBuild<64> { static __device__ __forceinline__ void run(const float (&)[64], float, unsigned&, unsigned&, unsigned&, unsigned&) {} };
constexpr int IKC_BYTES = 256 * 144;
__device__ __forceinline__ void idx_unit(Frame& F, int unit, const bf16* IQ, const bf16* IK, const float* IW, unsigned long long* MK) {
    int tid = F.tid; asm volatile("" : "+v"(tid));
    const int lane = tid & 63, wave = F.wave, c32 = lane & 31, hi = lane >> 5;
    const int b = unit & 3, g = 127 - (unit >> 2), t0 = g * 16;
    const int qa = t0 + 2 * wave, tq = qa + hi;
    const int nchunk = (t0 + 16 + 255) >> 8;
    LAS unsigned char* lds = F.lds;
    bf16x8v Af[4];
    { const int qsel = (c32 >> 2) & 1, head = (c32 & 3) + 4 * (c32 >> 3);
      const bf16* aptr = IQ + (size_t)(b * T + qa + qsel) * 1024 + head * 64 + 8 * hi;
#pragma unroll
      for (int ks = 0; ks < 4; ++ks) Af[ks] = *(const GAS bf16x8v*)(aptr + 16 * ks); }
    LAS float* wl = (LAS float*)(lds + 2 * IKC_BYTES) + (wave * 2 + hi) * 16;
    if (c32 < 16) wl[c32] = IW[(size_t)(b * T + tq) * 16 + c32];
    float sc[64];
#pragma unroll
    for (int i = 0; i < 64; ++i) sc[i] = -INFINITY;
    const bf16* ikb = IK + (size_t)b * T * 64;
    v4u stg[4];
    const int st_key = tid >> 1, st_half = tid & 1;
#define IDX_ISSUE(ch) do { const GAS v4u* src_ = (const GAS v4u*)(ikb + (size_t)((ch) * 256 + st_key) * 64 + st_half * 32); _Pragma("unroll") for (int j_ = 0; j_ < 4; ++j_) stg[j_] = src_[j_]; } while (0)
#define IDX_STORE(buf) do { LAS v4u* dst_ = (LAS v4u*)(lds + (buf) * IKC_BYTES + st_key * 144 + st_half * 64); _Pragma("unroll") for (int j_ = 0; j_ < 4; ++j_) dst_[j_] = stg[j_]; } while (0)
    IDX_ISSUE(0); IDX_STORE(0);
    __syncthreads();
#pragma unroll
    for (int ch = 0; ch < 8; ++ch) {
        if (ch < nchunk) {
            if (ch + 1 < nchunk) IDX_ISSUE(ch + 1);
            const LAS unsigned char* bb = lds + (ch & 1) * IKC_BYTES + c32 * 144 + hi * 16;
#pragma unroll
            for (int tl = 0; tl < 8; ++tl) {
                f32x16 acc = {};
#pragma unroll
                for (int ks = 0; ks < 4; ++ks) { const bf16x8v Bf = *(const LAS bf16x8v*)(bb + tl * 32 * 144 + ks * 32); acc = __builtin_amdgcn_mfma_f32_32x32x16_bf16(Af[ks], Bf, acc, 0, 0, 0); }
                float sv = 0.f;
#pragma unroll
                for (int r4 = 0; r4 < 4; ++r4) { const f32x4 wv = *(const LAS f32x4*)(wl + 4 * r4);
#pragma unroll
                    for (int r = 0; r < 4; ++r) sv = fmaf(wv[r], fmaxf(acc[4 * r4 + r], 0.f), sv); }
                const int key = (ch * 8 + tl) * 32 + c32;
                sv = (key > tq) ? -INFINITY : sv;
                asm volatile("" : "+v"(sv));
                sc[ch * 8 + tl] = sv;
            }
            if (ch + 1 < nchunk) IDX_STORE((ch + 1) & 1);
            __syncthreads();
        }
    }
#undef IDX_ISSUE
#undef IDX_STORE
    float thr = -3.0e38f;
    {
        const bool need = (tq + 1) > TOPK;
        float mn = INFINITY, mx = -INFINITY;
#pragma unroll
        for (int i = 0; i < 64; ++i) { const float v = sc[i]; mx = fmaxf(mx, v); mn = fminf(mn, (v == -INFINITY) ? INFINITY : v); }
        mn = half32_min_f(mn); mx = half32_max_f(mx);
        float lo = mn, hb = mx; bool done = !need;
#pragma unroll 1
        for (int it = 0; it < 64; ++it) {
            if (__builtin_amdgcn_ballot_w64(!done) == 0ull) break;
            const float mid = 0.5f * (lo + hb);
            int cnt = 0;
#pragma unroll
            for (int i = 0; i < 64; ++i) cnt += (sc[i] >= mid) ? 1 : 0;
            cnt = half32_sum_i(cnt);
            if (!done) {
                if (cnt == TOPK) { thr = mid; done = true; }
                else if (!(mid > lo && mid < hb)) { thr = lo; done = true; }
                else if (cnt > TOPK) lo = mid; else hb = mid;
            }
        }
        if (!done) thr = lo;
    }
    unsigned X = 0u, Y = 0u, Z = 0u, Wd = 0u;
    MaskBuild<0>::run(sc, thr, X, Y, Z, Wd);
    if (lane < 32) { v4u o; o.x = X; o.y = Y; o.z = Z; o.w = Wd; *(v4u*)(MK + ((size_t)(b * 32 + lane) * T + qa)) = o; }
    __syncthreads();
}
typedef float f32x2_t_ __attribute__((ext_vector_type(2))); typedef __bf16 bf16x2_t_ __attribute__((ext_vector_type(2)));
__device__ __forceinline__ unsigned cvtpk(float lo, float hi) { f32x2_t_ v = {lo, hi}; bf16x2_t_ b = __builtin_convertvector(v, bf16x2_t_); return __builtin_bit_cast(unsigned, b); }
typedef short v4i16_t __attribute__((ext_vector_type(4)));
__device__ __forceinline__ bf16x8v ldsB128(const LAS unsigned char* p) { return *(const LAS bf16x8v*)p; }
constexpr int SD_BP = 272, SD_XP = 528;
constexpr int SD_BS = 0, SD_XT = 256 * SD_BP, SD_CS = SD_XT + 64 * SD_XP, SD_DEC = SD_CS + 1024, SD_END = SD_DEC + 1024;
static_assert(SD_END <= RING_BYTES, "ssd lds");
__device__ __forceinline__ void ssd_pass1_unit(Frame& F, int unit, const bf16* XBC, const float* DT, const bf16* sB, const bf16* sC, const float* a_log, float* YD, float* ST, float* CS, float* TOT) {
    int tid = F.tid; asm volatile("" : "+v"(tid));
    const int lane = tid & 63, wave = F.wave, r32 = lane & 31, hi = lane >> 5;
    const int b = unit >> 5, g = (unit >> 3) & 3, c = unit & 7;
    const size_t row0 = (size_t)b * T + (size_t)c * 256;
    LAS unsigned char* lds = F.lds;
    { const int r = tid >> 1, hf = tid & 1; const GAS v4u* src = (const GAS v4u*)(sB + (row0 + r) * 512 + g * 128 + hf * 64); LAS v4u* dst = (LAS v4u*)(lds + SD_BS + r * SD_BP + hf * 128);
#pragma unroll
      for (int j = 0; j < 8; ++j) dst[j] = src[j]; }
#pragma unroll 1
    for (int hh = 0; hh < 3; ++hh) {
        const int h = 3 * g + hh;
        const float Ah = -expf(a_log[h]);
        LAS float* csb = (LAS float*)(lds + SD_CS); LAS float* decb = (LAS float*)(lds + SD_DEC);
        if (wave == 0) {
            float a4[4];
#pragma unroll
            for (int i = 0; i < 4; ++i) a4[i] = Ah * DT[(row0 + 4 * lane + i) * SH + h];
            a4[1] += a4[0]; a4[2] += a4[1]; a4[3] += a4[2];
            float x = a4[3];
            x += dpp_f<0x111>(x); x += dpp_f<0x112>(x); x += dpp_f<0x114>(x); x += dpp_f<0x118>(x);
            const float r0 = rdlane_f(x, 15), r1 = rdlane_f(x, 31), r2 = rdlane_f(x, 47);
            const int rw = lane >> 4; x += (rw >= 1 ? r0 : 0.f) + (rw >= 2 ? r1 : 0.f) + (rw >= 3 ? r2 : 0.f);
            const float tot = rdlane_f(x, 63);
            const float excl = x - a4[3];
#pragma unroll
            for (int i = 0; i < 4; ++i) { const float cv = excl + a4[i]; csb[4 * lane + i] = cv; decb[4 * lane + i] = fexp_(tot - cv); CS[(row0 + 4 * lane + i) * SH + h] = cv; }
            if (lane == 0) TOT[(b * SH + h) * 8 + c] = tot;
        }
        { const int l = tid >> 1, ph = tid & 1; const float dtl = DT[(row0 + l) * SH + h];
          const bf16* src = XBC + (row0 + l) * 768 + h * 64 + 32 * ph;
          const int s16 = l & 15, pos = (l & ~15) + 8 * ((s16 >> 2) & 1) + 4 * (s16 >> 3) + (s16 & 3);
          LAS bf16* xt = (LAS bf16*)(lds + SD_XT) + pos;
#pragma unroll
          for (int j = 0; j < 8; ++j) { const f32x4 v = ld4bf(src + 4 * j);
#pragma unroll
              for (int i = 0; i < 4; ++i) xt[(32 * ph + 4 * j + i) * (SD_XP / 2)] = (bf16)f2bf(v[i] * dtl); } }
        __syncthreads();
#pragma unroll 1
        for (int li = 0; li < 2; ++li) {
            const int ltile = li == 0 ? wave : 7 - wave;
            bf16x8v Cf[8];
            { const bf16* cp = sC + (row0 + 32 * ltile + r32) * 512 + g * 128 + 8 * hi;
#pragma unroll
              for (int ks = 0; ks < 8; ++ks) Cf[ks] = *(const GAS bf16x8v*)(cp + 16 * ks); }
            const float csl = csb[32 * ltile + r32];
            f32x16 YT0 = {}, YT1 = {};
#pragma unroll 1
            for (int stile = 0; stile <= ltile; ++stile) {
                f32x16 GT = {};
                const LAS unsigned char* bp = lds + SD_BS + (32 * stile + r32) * SD_BP + hi * 16;
#pragma unroll
                for (int ks = 0; ks < 8; ++ks) GT = __builtin_amdgcn_mfma_f32_32x32x16_bf16(ldsB128(bp + ks * 32), Cf[ks], GT, 0, 0, 0);
                const bool diag = (stile == ltile);
                unsigned pk[8];
#pragma unroll
                for (int q = 0; q < 4; ++q) { const f32x4 css = *(const LAS f32x4*)(csb + 32 * stile + 8 * q + 4 * hi);
                    float v[4];
#pragma unroll
                    for (int i = 0; i < 4; ++i) { const float e = __builtin_amdgcn_exp2f((csl - css[i]) * 1.4426950408889634f); v[i] = GT[4 * q + i] * e; if (diag && (8 * q + 4 * hi + i) > r32) v[i] = 0.f; }
                    pk[2 * q] = cvtpk(v[0], v[1]); pk[2 * q + 1] = cvtpk(v[2], v[3]); }
                bf16x8v G0, G1; { v4u t0 = {pk[0], pk[1], pk[2], pk[3]}, t1 = {pk[4], pk[5], pk[6], pk[7]}; G0 = __builtin_bit_cast(bf16x8v, t0); G1 = __builtin_bit_cast(bf16x8v, t1); }
                const LAS unsigned char* xp = lds + SD_XT + r32 * SD_XP + (32 * stile + 8 * hi) * 2;
                YT0 = __builtin_amdgcn_mfma_f32_32x32x16_bf16(ldsB128(xp), G0, YT0, 0, 0, 0);
                YT0 = __builtin_amdgcn_mfma_f32_32x32x16_bf16(ldsB128(xp + 32), G1, YT0, 0, 0, 0);
                YT1 = __builtin_amdgcn_mfma_f32_32x32x16_bf16(ldsB128(xp + 32 * SD_XP), G0, YT1, 0, 0, 0);
                YT1 = __builtin_amdgcn_mfma_f32_32x32x16_bf16(ldsB128(xp + 32 * SD_XP + 32), G1, YT1, 0, 0, 0);
            }
            float* yo = YD + (row0 + 32 * ltile + r32) * SW + h * 64 + 4 * hi;
#pragma unroll
            for (int q = 0; q < 4; ++q) { f32x4 o0 = {YT0[4 * q], YT0[4 * q + 1], YT0[4 * q + 2], YT0[4 * q + 3]}, o1 = {YT1[4 * q], YT1[4 * q + 1], YT1[4 * q + 2], YT1[4 * q + 3]};
                *(f32x4*)(yo + 8 * q) = o0; *(f32x4*)(yo + 32 + 8 * q) = o1; }
        }
        {
            const int pt = wave & 1, nt = wave >> 1;
            f32x16 acc = {};
            const LAS unsigned char* xp = lds + SD_XT + (32 * pt + r32) * SD_XP + 8 * hi * 2;
            const LAS unsigned char* bt = lds + SD_BS + (4 * hi + ((lane & 15) >> 2)) * SD_BP + (32 * nt + 16 * ((lane >> 4) & 1) + 4 * (lane & 3)) * 2;
#pragma unroll 4
            for (int kk = 0; kk < 16; ++kk) {
                const bf16x8v xa = ldsB128(xp + kk * 32);
                const f32x4 d0 = *(const LAS f32x4*)(decb + 16 * kk + 4 * hi), d1 = *(const LAS f32x4*)(decb + 16 * kk + 8 + 4 * hi);
                const v4u xu = __builtin_bit_cast(v4u, xa); unsigned po[4];
#pragma unroll
                for (int w2 = 0; w2 < 4; ++w2) { const float lo = __builtin_bit_cast(float, xu[w2] << 16), hv = __builtin_bit_cast(float, xu[w2] & 0xffff0000u);
                    const float dl = (w2 < 2) ? d0[2 * w2] : d1[2 * (w2 - 2)], dh = (w2 < 2) ? d0[2 * w2 + 1] : d1[2 * (w2 - 2) + 1];
                    po[w2] = cvtpk(lo * dl, hv * dh); }
                const v4u pa = {po[0], po[1], po[2], po[3]};
                const v4i16_t blo = __builtin_amdgcn_ds_read_tr16_b64_v4i16((LAS v4i16_t*)(bt + kk * 16 * SD_BP));
                const v4i16_t bhi = __builtin_amdgcn_ds_read_tr16_b64_v4i16((LAS v4i16_t*)(bt + kk * 16 * SD_BP + 8 * SD_BP));
                const bf16x8v bfr = {blo[0], blo[1], blo[2], blo[3], bhi[0], bhi[1], bhi[2], bhi[3]};
                acc = __builtin_amdgcn_mfma_f32_32x32x16_bf16(__builtin_bit_cast(bf16x8v, pa), bfr, acc, 0, 0, 0);
            }
            float* so = ST + ((size_t)((b * SH + h) * 8 + c) * 64 + 32 * pt) * 128 + 32 * nt + r32;
#pragma unroll
            for (int r = 0; r < 16; ++r) so[(size_t)((r & 3) + 8 * (r >> 2) + 4 * hi) * 128] = acc[r];
        }
        __syncthreads();
    }
}
constexpr int S2_SP = 272;
__device__ __forceinline__ void ssd_pass2_unit(Frame& F, int unit, const bf16* XBC, const bf16* UUp, const bf16* sC, const float* YD, const float* ST, const float* CS, const float* TOT, const float* d_skip, const float* norm_w, bf16* cat) {
    int tid = F.tid; asm volatile("" : "+v"(tid));
    const int lane = tid & 63, wave = F.wave, r32 = lane & 31, hi = lane >> 5;
    const int b = unit >> 5, g = (unit >> 3) & 3, c = unit & 7;
    const size_t row0 = (size_t)b * T + (size_t)c * 256;
    LAS unsigned char* lds = F.lds;
#pragma unroll 1
    for (int hh = 0; hh < 3; ++hh) {
        const int h = 3 * g + hh; const int p = tid >> 3, n0 = (tid & 7) * 16;
        f32x4 S[4] = {};
        for (int cc = 0; cc < c; ++cc) { const float dk = fexp_(TOT[(b * SH + h) * 8 + cc]); const GAS f32x4* sp = (const GAS f32x4*)(ST + ((size_t)((b * SH + h) * 8 + cc) * 64 + p) * 128 + n0);
#pragma unroll
            for (int j = 0; j < 4; ++j) S[j] = S[j] * dk + sp[j]; }
        v4u o0 = {pg8::cvt_pk_bf16(S[0][0], S[0][1]), pg8::cvt_pk_bf16(S[0][2], S[0][3]), pg8::cvt_pk_bf16(S[1][0], S[1][1]), pg8::cvt_pk_bf16(S[1][2], S[1][3])};
        v4u o1 = {pg8::cvt_pk_bf16(S[2][0], S[2][1]), pg8::cvt_pk_bf16(S[2][2], S[2][3]), pg8::cvt_pk_bf16(S[3][0], S[3][1]), pg8::cvt_pk_bf16(S[3][2], S[3][3])};
        LAS v4u* dst = (LAS v4u*)(lds + (hh * 64 + p) * S2_SP + n0 * 2); dst[0] = o0; dst[1] = o1;
    }
    __syncthreads();
    const size_t l = row0 + 32 * wave + r32;
    bf16x8v Cf[8];
    { const bf16* cp = sC + l * 512 + g * 128 + 8 * hi;
#pragma unroll
      for (int ks = 0; ks < 8; ++ks) Cf[ks] = *(const GAS bf16x8v*)(cp + 16 * ks); }
    f32x16 acc[3][2];
#pragma unroll
    for (int hh = 0; hh < 3; ++hh)
#pragma unroll
        for (int pt = 0; pt < 2; ++pt) { f32x16 a = {};
            const LAS unsigned char* sp = lds + (hh * 64 + 32 * pt + r32) * S2_SP + hi * 16;
#pragma unroll
            for (int ks = 0; ks < 8; ++ks) a = __builtin_amdgcn_mfma_f32_32x32x16_bf16(ldsB128(sp + ks * 32), Cf[ks], a, 0, 0, 0);
            acc[hh][pt] = a; }
    float ss = 0.f;
#pragma unroll
    for (int hh = 0; hh < 3; ++hh) { const int h = 3 * g + hh; const float ecs = fexp_(CS[l * SH + h]), Dh = d_skip[h];
#pragma unroll
        for (int pt = 0; pt < 2; ++pt)
#pragma unroll
            for (int q = 0; q < 4; ++q) { const int col = h * 64 + 32 * pt + 8 * q + 4 * hi;
                const f32x4 yd = *(const GAS f32x4*)(YD + l * SW + col), xs = ld4bf(XBC + l * 768 + col), z4 = ld4bf(UUp + l * DINP + U_Z + col);
#pragma unroll
                for (int i = 0; i < 4; ++i) { const float y = yd[i] + ecs * acc[hh][pt][4 * q + i] + Dh * xs[i]; const float gv = y * siluf_(z4[i]); acc[hh][pt][4 * q + i] = gv; ss += gv * gv; } } }
    { auto rr = __builtin_amdgcn_permlane32_swap(__builtin_bit_cast(unsigned, ss), __builtin_bit_cast(unsigned, ss), false, false); const unsigned r0_ = rr[0], r1_ = rr[1]; ss = __builtin_bit_cast(float, r0_) + __builtin_bit_cast(float, r1_); }
    const float rms = __builtin_amdgcn_rsqf(ss * (1.f / 192.f) + 1e-5f);
#pragma unroll
    for (int hh = 0; hh < 3; ++hh) { const int h = 3 * g + hh;
#pragma unroll
        for (int pt = 0; pt < 2; ++pt)
#pragma unroll
            for (int q = 0; q < 4; ++q) { const int col = h * 64 + 32 * pt + 8 * q + 4 * hi; const f32x4 nw = *(const GAS f32x4*)(norm_w + col);
                v2u o; o.x = pg8::cvt_pk_bf16(acc[hh][pt][4 * q] * rms * nw[0], acc[hh][pt][4 * q + 1] * rms * nw[1]); o.y = pg8::cvt_pk_bf16(acc[hh][pt][4 * q + 2] * rms * nw[2], acc[hh][pt][4 * q + 3] * rms * nw[3]);
                *(GAS v2u*)(cat + l * D + AW + RW + col) = o; } }
    __syncthreads();
}

constexpr int PV_AP = 528, PV_VP = 1552;
constexpr int PV_ACT = 0, PV_V = 32 * PV_AP, PV_P32 = PV_V + 32 * PV_VP;
constexpr int PV_CH = PV_V, PV_CHB = 32 * 256 * 4;
constexpr int PV_V32 = PV_CH + 3 * PV_CHB, PV_END = PV_V32 + 32 * 80;
static_assert(PV_P32 + 8 * 4096 <= PV_V32 && PV_END <= RING_BYTES, "prep lds");
static_assert(PV_END <= RING_BYTES, "prep lds");
struct PrepBufs { float *Wd, *V, *VF, *DT; bf16 *R, *K, *A, *Bv, *G, *XBC, *sB, *sC, *Q, *Kb, *Vb, *IQ, *IK; float* IW; const float *rc, *rs; const bf16* lw; };
__device__ __forceinline__ void prep_unit(Frame& F, int unit, const bf16* u, const MixW& w, const PrepBufs& P) {
    int tid = F.tid; asm volatile("" : "+v"(tid));
    const int lane = tid & 63, wave = F.wave, r32 = lane & 31, hi = lane >> 5;
    const size_t m0 = (size_t)unit * 32; const int t0 = (int)(m0 & (T - 1));
    LAS unsigned char* lds = F.lds;
    {
        const int tl = tid >> 4, l16 = tid & 15; const size_t m = m0 + tl; const bool hasprev = (t0 + tl) > 0;
        const bf16* ur = u + m * DINP + U_RW;
        const f32x4 zero4 = {0.f, 0.f, 0.f, 0.f};
        const v2u zero2 = {0u, 0u}; (void)zero4;
        v2u rc_[2][4], rp_[2][4]; f32x4 rm_[2][4];
#define PREP_ISSUE(S, IT0) { _Pragma("unroll") for (int q_ = 0; q_ < 4; ++q_) { const int c_ = 64 * ((IT0) + q_) + 4 * l16; rc_[S][q_] = *(const GAS v2u*)(ur + c_); \
            rp_[S][q_] = hasprev ? *(const GAS v2u*)(ur - DINP + c_) : zero2; rm_[S][q_] = *(const GAS f32x4*)(w.mu + c_); } }
#define PREP_FIN(S) f32x4 xs_[4]; { _Pragma("unroll") for (int q_ = 0; q_ < 4; ++q_) { const f32x4 cur_ = cvt4bf(rc_[S][q_]), prv_ = cvt4bf(rp_[S][q_]); xs_[q_] = cur_ + (prv_ - cur_) * rm_[S][q_]; } }
#define R_BODY(I4) { _Pragma("unroll") for (int q = 0; q < 4; ++q) *(LAS f32x4*)(lds + PV_CH + (tl * 256 + 64 * q + 4 * l16) * 4) = xs_[q]; }
#define K_BODY(I4) { _Pragma("unroll") for (int q = 0; q < 4; ++q) { const f32x4 kq = xs_[q] * kk4[q]; \
            const float ss = row16_sum((kq[0] * kq[0] + kq[1] * kq[1]) + (kq[2] * kq[2] + kq[3] * kq[3])); const float inv = -__builtin_amdgcn_rsqf(fmaxf(ss, 1e-24f)); \
            *(LAS f32x4*)(lds + PV_CH + 2 * PV_CHB + (tl * 256 + 64 * q + 4 * l16) * 4) = kq * inv; *(LAS f32x4*)(lds + PV_CH + PV_CHB + (tl * 256 + 64 * q + 4 * l16) * 4) = xs_[q]; } }
#define KK_LOAD(I4) f32x4 kk4[4]; { _Pragma("unroll") for (int q = 0; q < 4; ++q) kk4[q] = *(const GAS f32x4*)(w.k_k + 64 * (4 * (I4) + q) + 4 * l16 - 768); }
#define PREP_STEP1_VARS() const int tl = tid >> 4, l16 = tid & 15; const size_t m = m0 + tl; const bool hasprev = (t0 + tl) > 0; const bf16* ur = u + m * DINP + U_RW; const v2u zero2 = {0u, 0u}; (void)m; v2u rc_[2][4], rp_[2][4]; f32x4 rm_[2][4];
#define V_BODY(I4) { _Pragma("unroll") for (int q = 0; q < 4; ++q) { const int cc = 64 * (4 * (I4) + q) + 4 * l16 - 1536; \
            if (w.layer == 0) *(GAS f32x4*)(P.VF + m * RW + cc) = xs_[q];        \
            else { *(GAS f32x4*)(P.V + m * RW + cc) = xs_[q]; v2u o; o.x = pg8::cvt_pk_bf16(xs_[q][0], xs_[q][1]); o.y = pg8::cvt_pk_bf16(xs_[q][2], xs_[q][3]); *(LAS v2u*)(lds + PV_V + tl * PV_VP + cc * 2) = o; } } }
        PREP_ISSUE(0, 24)
        { PREP_ISSUE(1, 28) PREP_FIN(0) V_BODY(6) }
        { PREP_ISSUE(0, 32) PREP_FIN(1) V_BODY(7) }
        { PREP_ISSUE(1, 36) PREP_FIN(0) V_BODY(8) }
        { PREP_FIN(1)
#pragma unroll
            for (int q = 0; q < 4; ++q) { const int cc = 64 * q + 4 * l16; f32x4 a4; const f32x4 xq = xs_[q];
                if (q == 0) { a4[0] = ftanh_(xq[0]); a4[1] = ftanh_(xq[1]); a4[2] = ftanh_(xq[2]); a4[3] = ftanh_(xq[3]); }
                else if (q == 1) a4 = xq;
                else { a4[0] = sigmoidf_(xq[0]); a4[1] = sigmoidf_(xq[1]); a4[2] = sigmoidf_(xq[2]); a4[3] = sigmoidf_(xq[3]); }
                v2u o; o.x = pg8::cvt_pk_vis(a4[0], a4[1]); o.y = pg8::cvt_pk_vis(a4[2], a4[3]); *(LAS v2u*)(lds + PV_ACT + tl * PV_AP + cc * 2) = o; } }
#undef V_BODY
    }
    __syncthreads();
    if (w.layer > 0) {
        f32x16 acc = {};
        const LAS unsigned char* ap = lds + PV_V + r32 * PV_VP + hi * 16; const bf16* bp = P.lw + LW_V1 + (size_t)r32 * 768 + 8 * hi;
#pragma unroll
        for (int k6 = 0; k6 < 6; ++k6) { const int ks = wave * 6 + k6; acc = __builtin_amdgcn_mfma_f32_32x32x16_bf16(ldsB128(ap + ks * 32), *(const GAS bf16x8v*)(bp + ks * 16), acc, 0, 0, 0); }
        LAS float* pp = (LAS float*)(lds + PV_P32 + wave * 4096);
#pragma unroll
        for (int r = 0; r < 16; ++r) pp[((r & 3) + 8 * (r >> 2) + 4 * hi) * 32 + r32] = acc[r];
        __syncthreads();
        { const int e0 = tid * 2; float s0 = 0.f, s1 = 0.f;
#pragma unroll
          for (int wv = 0; wv < 8; ++wv) { const LAS float* q = (const LAS float*)(lds + PV_P32 + wv * 4096) + e0; s0 += q[0]; s1 += q[1]; }
          *(LAS unsigned*)(lds + PV_V32 + (e0 >> 5) * 80 + (e0 & 31) * 2) = pg8::cvt_pk_bf16(s0, s1); }
        __syncthreads();
    }
#pragma unroll 1
    for (int j = 0; j < 3; ++j) {
        { PREP_STEP1_VARS()
          KK_LOAD(3 + j) PREP_ISSUE(0, 4 * j)
          { PREP_ISSUE(1, 12 + 4 * j) PREP_FIN(0) R_BODY(j) }
          { PREP_FIN(1) K_BODY(3 + j) } }
        __syncthreads();
        const int ct = 8 * j + wave, c = 32 * ct + r32;
        const LAS float* chl = (const LAS float*)(lds + PV_CH) + 32 * wave + r32;
        f32x16 accW = {}, accA = {}, accG = {}, accV = {};
        const LAS unsigned char* ap = lds + PV_ACT + r32 * PV_AP + hi * 16;
        const bf16* bw = P.lw + LW_W2 + (size_t)c * 64 + 8 * hi; const bf16* ba = P.lw + LW_A2 + (size_t)c * 64 + 8 * hi; const bf16* bg = P.lw + LW_G2 + (size_t)c * 128 + 8 * hi;
#pragma unroll
        for (int ks = 0; ks < 4; ++ks) { accW = __builtin_amdgcn_mfma_f32_32x32x16_bf16(ldsB128(ap + ks * 32), *(const GAS bf16x8v*)(bw + ks * 16), accW, 0, 0, 0);
                                         accA = __builtin_amdgcn_mfma_f32_32x32x16_bf16(ldsB128(ap + 128 + ks * 32), *(const GAS bf16x8v*)(ba + ks * 16), accA, 0, 0, 0); }
#pragma unroll
        for (int ks = 0; ks < 8; ++ks) accG = __builtin_amdgcn_mfma_f32_32x32x16_bf16(ldsB128(ap + 256 + ks * 32), *(const GAS bf16x8v*)(bg + ks * 16), accG, 0, 0, 0);
        if (w.layer > 0) { const LAS unsigned char* vp = lds + PV_V32 + r32 * 80 + hi * 16; const bf16* bv = P.lw + LW_V2 + (size_t)c * 32 + 8 * hi;
#pragma unroll
            for (int ks = 0; ks < 2; ++ks) accV = __builtin_amdgcn_mfma_f32_32x32x16_bf16(ldsB128(vp + ks * 32), *(const GAS bf16x8v*)(bv + ks * 16), accV, 0, 0, 0); }
        {
            bf16* gp = P.G + (m0 + 4 * hi) * RW + c;
#pragma unroll
            for (int r = 0; r < 16; ++r) gp[((r & 3) + 8 * (r >> 2)) * RW] = (bf16)(pg8::cvt_pk_vis(accG[r], accG[r]) & 0xffffu); }
        const float w0c = w.w0[c], a0c = w.a0[c], kac = w.k_a[c], v0c = (w.layer > 0) ? w.v0[c] : 0.f;
        float dec[16], av[16];
#pragma unroll
        for (int r = 0; r < 16; ++r) { const float w_log = -softplusf_(-(accW[r] + w0c)) - 0.5f; dec[r] = fexp_(-fexp_(w_log)); av[r] = sigmoidf_(accA[r] + a0c); }
        float Wc[16], Wp[16];
        { float run = 1.f;
#pragma unroll
          for (int q = 0; q < 4; ++q) {
              const float p0 = dec[4 * q], p1 = p0 * dec[4 * q + 1], p2 = p1 * dec[4 * q + 2], p3 = p2 * dec[4 * q + 3];
              auto rr = __builtin_amdgcn_permlane32_swap(__builtin_bit_cast(unsigned, p3), __builtin_bit_cast(unsigned, p3), false, false);
              const unsigned r0_ = rr[0], r1_ = rr[1]; const float gp = (hi == 0) ? __builtin_bit_cast(float, r1_) : __builtin_bit_cast(float, r0_);
              const float E = (hi == 0) ? run : run * gp;
              Wp[4 * q] = E; Wc[4 * q] = E * p0; Wp[4 * q + 1] = Wc[4 * q]; Wc[4 * q + 1] = E * p1; Wp[4 * q + 2] = Wc[4 * q + 1]; Wc[4 * q + 2] = E * p2; Wp[4 * q + 3] = Wc[4 * q + 2]; Wc[4 * q + 3] = E * p3;
              run = run * (p3 * gp);
          }
          if (hi == 0) P.Wd[(size_t)unit * RW + c] = run; }
        if (w.layer > 0) {
            float vv[16], vf[16];
#pragma unroll
            for (int r = 0; r < 16; ++r) { const size_t o = (m0 + (r & 3) + 8 * (r >> 2) + 4 * hi) * RW + c; vv[r] = P.V[o]; vf[r] = P.VF[o]; }
#pragma unroll
            for (int r = 0; r < 16; ++r) { const size_t o = (m0 + (r & 3) + 8 * (r >> 2) + 4 * hi) * RW + c; P.V[o] = vv[r] + (vf[r] - vv[r]) * sigmoidf_(accV[r] + v0c); } }
#pragma unroll
        for (int r = 0; r < 16; ++r) { const int tok = (r & 3) + 8 * (r >> 2) + 4 * hi; const size_t o = (m0 + tok) * RW + c;
            const float rq = chl[tok * 256], kr = chl[32 * 256 + tok * 256], nk = chl[2 * 32 * 256 + tok * 256];
            const float iW = frcp_(Wc[r]);
            const unsigned kb2 = pg8::cvt_pk_vis(kr * (1.f + (av[r] - 1.f) * kac) * iW, -nk * av[r] * iW), ar2 = pg8::cvt_pk_vis(nk * Wp[r], rq * Wc[r]);
            P.K[o] = (bf16)(kb2 & 0xffffu); P.Bv[o] = (bf16)(kb2 >> 16); P.A[o] = (bf16)(ar2 & 0xffffu); P.R[o] = (bf16)(ar2 >> 16); }
        __syncthreads();
    }
#undef PREP_ISSUE
#undef PREP_FIN
#undef R_BODY
#undef K_BODY
#undef KK_LOAD
#undef PREP_STEP1_VARS
    if (tid < 448) {
        const int c = 4 * tid; const bf16* ub = u + m0 * DINP + U_XBC + c;
        f32x4 wt[4];
#pragma unroll
        for (int ch = 0; ch < 4; ++ch) wt[ch] = *(const GAS f32x4*)(w.conv_w + (size_t)(c + ch) * 4);
        const f32x4 cb = *(const GAS f32x4*)(w.conv_b + c);
        const f32x4 z4 = {0.f, 0.f, 0.f, 0.f};
        f32x4 x0 = (t0 >= 3) ? ld4bf(ub - 3 * (size_t)DINP) : z4, x1 = (t0 >= 2) ? ld4bf(ub - 2 * (size_t)DINP) : z4, x2 = (t0 >= 1) ? ld4bf(ub - (size_t)DINP) : z4;
        v2u xr[32];
#pragma unroll
        for (int tt = 0; tt < 32; ++tt) xr[tt] = *(const GAS v2u*)(ub + (size_t)tt * DINP);
#pragma unroll
        for (int tt = 0; tt < 32; ++tt) {
            const f32x4 x3 = cvt4bf(xr[tt]);
            f32x4 y;
#pragma unroll
            for (int ch = 0; ch < 4; ++ch) y[ch] = siluf_(cb[ch] + wt[ch][0] * x0[ch] + wt[ch][1] * x1[ch] + wt[ch][2] * x2[ch] + wt[ch][3] * x3[ch]);
            { v2u o; o.x = pg8::cvt_pk_bf16(y[0], y[1]); o.y = pg8::cvt_pk_bf16(y[2], y[3]);
              bf16* d = (c < 768) ? P.XBC + (m0 + tt) * 768 + c : (c >= 1280) ? P.sC + (m0 + tt) * 512 + (c - 1280) : P.sB + (m0 + tt) * 512 + (c - 768); *(GAS v2u*)d = o; }
            x0 = x1; x1 = x2; x2 = x3;
        }
    } else if (tid < 448 + SH) {
        const int h = tid - 448; const float bias = w.dt_bias[h];
        float dv[32];
#pragma unroll
        for (int tt = 0; tt < 32; ++tt) dv[tt] = bf2f(u[(m0 + tt) * DINP + U_DT + h]);
#pragma unroll
        for (int tt = 0; tt < 32; ++tt) P.DT[(m0 + tt) * SH + h] = softplusf_(dv[tt] + bias);
    }
#define ROPE_IDX(idx_) const int tl = (idx_) / 264, sl = (idx_) - tl * 264; const size_t m = m0 + tl; const int hh = sl >> 3, j0 = (sl & 7) * 4; \
        const int so = (hh < 8) ? U_Q + hh * 64 : (hh < 16) ? U_K + (hh - 8) * 64 : (hh < 32) ? U_IQ + (hh - 16) * 64 : U_IK; const bf16* src = u + m * DINP + so + j0;
#define ROPE_OUT(x1r, x2r, cv, sv) { const f32x4 x1 = cvt4bf(x1r), x2 = cvt4bf(x2r); \
        bf16* dst = (hh < 8) ? P.Q + m * AW + hh * 64 : (hh < 16) ? P.Kb + m * AW + (hh - 8) * 64 : (hh < 32) ? P.IQ + m * 1024 + (hh - 16) * 64 : P.IK + m * 64; \
        const float sc = (hh < 8) ? ATT_C2 : 1.f; const f32x4 o1 = (x1 * cv - x2 * sv) * sc, o2 = (x2 * cv + x1 * sv) * sc; \
        v2u a; a.x = pg8::cvt_pk_bf16(o1[0], o1[1]); a.y = pg8::cvt_pk_bf16(o1[2], o1[3]); *(GAS v2u*)(dst + j0) = a; \
        v2u b; b.x = pg8::cvt_pk_bf16(o2[0], o2[1]); b.y = pg8::cvt_pk_bf16(o2[2], o2[3]); *(GAS v2u*)(dst + j0 + 32) = b; }
#pragma unroll 1
    for (int bt = 0; bt < 2; ++bt) {
        v2u xa[8], xb[8]; f32x4 cva[8], sva[8];
#pragma unroll
        for (int i = 0; i < 8; ++i) { ROPE_IDX(tid + NTHR * (8 * bt + i)) xa[i] = *(const GAS v2u*)src; xb[i] = *(const GAS v2u*)(src + 32); cva[i] = *(const GAS f32x4*)(P.rc + m * 32 + j0); sva[i] = *(const GAS f32x4*)(P.rs + m * 32 + j0); }
#pragma unroll
        for (int i = 0; i < 8; ++i) { ROPE_IDX(tid + NTHR * (8 * bt + i)) (void)src; ROPE_OUT(xa[i], xb[i], cva[i], sva[i]) }
    }
    if (tid < 256) { ROPE_IDX(tid + NTHR * 16) const v2u xa = *(const GAS v2u*)src, xb = *(const GAS v2u*)(src + 32); const f32x4 cv = *(const GAS f32x4*)(P.rc + m * 32 + j0), sv = *(const GAS f32x4*)(P.rs + m * 32 + j0); ROPE_OUT(xa, xb, cv, sv) }
#undef ROPE_IDX
#undef ROPE_OUT
    v2u vcp[8];
#pragma unroll
    for (int i = 0; i < 8; ++i) {
        const int idx = tid + NTHR * i, tl = idx >> 7, j0 = (idx & 127) * 4; const size_t m = m0 + tl;
        vcp[i] = *(const GAS v2u*)(u + m * DINP + U_V + j0); }
#pragma unroll
    for (int i = 0; i < 8; ++i) { const int idx = tid + NTHR * i, tl = idx >> 7, j0 = (idx & 127) * 4; const size_t m = m0 + tl; *(GAS v2u*)(P.Vb + m * AW + j0) = vcp[i]; }
    if (tid < 128) { const int tl = tid >> 2, j0 = (tid & 3) * 4; const size_t m = m0 + tl; const f32x4 x = ld4bf(u + m * DINP + U_IW + j0); *(GAS f32x4*)(P.IW + m * 16 + j0) = x * (0.25f * 0.125f); }
    __syncthreads();
}

constexpr int SC_CH = 32;
constexpr int SC_COEF = SC_CH * 4 * 64 * 4;
constexpr int SC_VS = SC_CH + 4;
constexpr int SC_VT = 32 * SC_VS * 4;
constexpr int SC_YB = SC_CH * 4 * 32 * 4;
constexpr int SC_WE = 256;
constexpr int SC_BUF = SC_COEF + SC_VT + SC_YB + SC_WE;
static_assert(2 * SC_BUF <= RING_BYTES, "scan lds");
__device__ __forceinline__ float row8_sum(float x) {
    x += dpp_f<0xB1>(x); x += dpp_f<0x4E>(x); x += dpp_f<0x141>(x); return x;
}
__device__ __forceinline__ void row16_sum4(float& a, float& b, float& c, float& d, float a1, float b1, float c1, float d1) {
    asm("v_add_f32_e32 %0, %0, %4\n\tv_add_f32_e32 %1, %1, %5\n\tv_add_f32_e32 %2, %2, %6\n\tv_add_f32_e32 %3, %3, %7\n\t"
        "v_add_f32_dpp %0, %0, %0 quad_perm:[1,0,3,2] row_mask:0xf bank_mask:0xf\n\tv_add_f32_dpp %1, %1, %1 quad_perm:[1,0,3,2] row_mask:0xf bank_mask:0xf\n\t"
        "v_add_f32_dpp %2, %2, %2 quad_perm:[1,0,3,2] row_mask:0xf bank_mask:0xf\n\tv_add_f32_dpp %3, %3, %3 quad_perm:[1,0,3,2] row_mask:0xf bank_mask:0xf\n\t"
        "v_add_f32_dpp %0, %0, %0 quad_perm:[2,3,0,1] row_mask:0xf bank_mask:0xf\n\tv_add_f32_dpp %1, %1, %1 quad_perm:[2,3,0,1] row_mask:0xf bank_mask:0xf\n\t"
        "v_add_f32_dpp %2, %2, %2 quad_perm:[2,3,0,1] row_mask:0xf bank_mask:0xf\n\tv_add_f32_dpp %3, %3, %3 quad_perm:[2,3,0,1] row_mask:0xf bank_mask:0xf\n\t"
        "v_add_f32_dpp %0, %0, %0 row_half_mirror row_mask:0xf bank_mask:0xf\n\tv_add_f32_dpp %1, %1, %1 row_half_mirror row_mask:0xf bank_mask:0xf\n\t"
        "v_add_f32_dpp %2, %2, %2 row_half_mirror row_mask:0xf bank_mask:0xf\n\tv_add_f32_dpp %3, %3, %3 row_half_mirror row_mask:0xf bank_mask:0xf\n\t"
        "v_add_f32_dpp %0, %0, %0 row_mirror row_mask:0xf bank_mask:0xf\n\tv_add_f32_dpp %1, %1, %1 row_mirror row_mask:0xf bank_mask:0xf\n\t"
        "v_add_f32_dpp %2, %2, %2 row_mirror row_mask:0xf bank_mask:0xf\n\tv_add_f32_dpp %3, %3, %3 row_mirror row_mask:0xf bank_mask:0xf"
        : "+v"(a), "+v"(b), "+v"(c), "+v"(d) : "v"(a1), "v"(b1), "v"(c1), "v"(d1));
}
__device__ __forceinline__ void row16_sum2_quad2(float& a, float& b, float& c, float& d, float a1, float b1, float c1, float d1) {
    asm("v_add_f32_e32 %0, %0, %4\n\tv_add_f32_e32 %1, %1, %5\n\tv_add_f32_e32 %2, %2, %6\n\tv_add_f32_e32 %3, %3, %7\n\t"
        "v_add_f32_dpp %0, %0, %0 quad_perm:[1,0,3,2] row_mask:0xf bank_mask:0xf\n\tv_add_f32_dpp %1, %1, %1 quad_perm:[1,0,3,2] row_mask:0xf bank_mask:0xf\n\t"
        "v_add_f32_dpp %2, %2, %2 quad_perm:[1,0,3,2] row_mask:0xf bank_mask:0xf\n\tv_add_f32_dpp %3, %3, %3 quad_perm:[1,0,3,2] row_mask:0xf bank_mask:0xf\n\t"
        "v_add_f32_dpp %0, %0, %0 quad_perm:[2,3,0,1] row_mask:0xf bank_mask:0xf\n\tv_add_f32_dpp %1, %1, %1 quad_perm:[2,3,0,1] row_mask:0xf bank_mask:0xf\n\t"
        "v_add_f32_dpp %2, %2, %2 quad_perm:[2,3,0,1] row_mask:0xf bank_mask:0xf\n\tv_add_f32_dpp %3, %3, %3 quad_perm:[2,3,0,1] row_mask:0xf bank_mask:0xf\n\t"
        "v_add_f32_dpp %0, %0, %0 row_half_mirror row_mask:0xf bank_mask:0xf\n\tv_add_f32_dpp %1, %1, %1 row_half_mirror row_mask:0xf bank_mask:0xf\n\ts_nop 0\n\t"
        "v_add_f32_dpp %0, %0, %0 row_mirror row_mask:0xf bank_mask:0xf\n\tv_add_f32_dpp %1, %1, %1 row_mirror row_mask:0xf bank_mask:0xf"
        : "+v"(a), "+v"(b), "+v"(c), "+v"(d) : "v"(a1), "v"(b1), "v"(c1), "v"(d1));
}
__device__ __forceinline__ f32x2 dot4h(const f32x4 s, const f32x4 c) { const f32x2 l = s.xy * c.xy; return s.zw * c.zw + l; }
__device__ __forceinline__ void rwkv_scan_unit(Frame& F, int unit, const bf16* R, const float* Wend, const bf16* K, const float* V, const bf16* A, const bf16* Bv, float* Y) {
    const int chain = unit >> 1, rh = unit & 1, b = chain / RH, h = chain % RH;
    int tid = F.tid; asm volatile("" : "+v"(tid));
    const int lane = tid & 63, wave = F.wave;
    const size_t base = (size_t)b * T * RW + h * 64;
    LAS unsigned char* lds = F.lds;
    const bool helper = wave >= 4; const int ht = tid - 256;
    f32x4 pre[8]; f32x4 prev_, prew_;
    const bf16* gsrc[4] = {A, Bv, K, R};
    auto issue_loads = [&](int c) {
#pragma unroll
        for (int i = 0; i < 8; ++i) { const int idx = ht + 256 * i, arr = idx >> 9, step = (idx >> 4) & 31, part = idx & 15;
            pre[i] = ld4bf(gsrc[arr] + base + (size_t)(c * SC_CH + step) * RW + part * 4); }
        prev_ = *(const GAS f32x4*)(V + base + (size_t)(c * SC_CH + (ht >> 3)) * RW + 32 * rh + (ht & 7) * 4);
        if (ht < 16) prew_ = *(const GAS f32x4*)(Wend + ((size_t)(b * (T / SC_CH) + c)) * RW + h * 64 + ht * 4);
    };
    auto store_lds = [&](int buf) {
        LAS float* cf = (LAS float*)(lds + buf * SC_BUF);
#pragma unroll
        for (int i = 0; i < 8; ++i) { const int idx = ht + 256 * i, arr = idx >> 9, step = (idx >> 4) & 31, part = idx & 15;
            *(LAS f32x4*)(cf + (step * 4 + arr) * 64 + part * 4) = pre[i]; }
        LAS float* vt = (LAS float*)(lds + buf * SC_BUF + SC_COEF);
#pragma unroll
        for (int j = 0; j < 4; ++j) vt[((ht & 7) * 4 + j) * SC_VS + (ht >> 3)] = prev_[j];
        if (ht < 16) *(LAS f32x4*)(lds + buf * SC_BUF + SC_COEF + SC_VT + SC_YB + ht * 16) = prew_;
    };
    if (helper) { issue_loads(0); store_lds(0); }
    __syncthreads();
    const int rp = lane >> 4, c4 = lane & 15, row0 = 8 * (wave & 3) + 2 * rp;
    f32x4 s0 = {0.f, 0.f, 0.f, 0.f}, s1 = {0.f, 0.f, 0.f, 0.f};
    constexpr int NCH = T / SC_CH;
#pragma unroll 1
    for (int c = 0; c < NCH; ++c) {
        const int buf = c & 1;
        if (helper) { if (c + 1 < NCH) issue_loads(c + 1); }
        else {
            const LAS float* cf = (const LAS float*)(lds + buf * SC_BUF) + c4 * 4;
            const LAS float* vt0 = (const LAS float*)(lds + buf * SC_BUF + SC_COEF) + row0 * SC_VS; const LAS float* vt1 = vt0 + SC_VS;
            LAS float* yb = (LAS float*)(lds + buf * SC_BUF + SC_COEF + SC_VT) + (c4 >> 2) * 32 + row0;
            f32x4 ca = *(const LAS f32x4*)(cf), cb = *(const LAS f32x4*)(cf + 64), ck = *(const LAS f32x4*)(cf + 128), cq = *(const LAS f32x4*)(cf + 192);
            f32x4 pq = cq;
            f32x4 na = *(const LAS f32x4*)(cf + 256), nb = *(const LAS f32x4*)(cf + 256 + 64), nk = *(const LAS f32x4*)(cf + 256 + 128), nq = *(const LAS f32x4*)(cf + 256 + 192);
#pragma unroll
            for (int g4 = 0; g4 < SC_CH / 4; ++g4) {
                const f32x4 v40 = *(const LAS f32x4*)(vt0 + g4 * 4), v41 = *(const LAS f32x4*)(vt1 + g4 * 4);
#pragma unroll
                for (int j = 0; j < 4; ++j) {
                    const int st = g4 * 4 + j; const LAS float* cn = cf + ((st + 2) & (SC_CH - 1)) * 256;
                    const f32x4 ma = *(const LAS f32x4*)(cn), mb = *(const LAS f32x4*)(cn + 64), mk = *(const LAS f32x4*)(cn + 128), mq = *(const LAS f32x4*)(cn + 192);
                    __builtin_amdgcn_sched_barrier(0);
                    const float vv0 = v40[j], vv1 = v41[j];
                    const f32x2 pa0 = dot4h(s0, ca), pa1 = dot4h(s1, ca);
                    const f32x2 py0 = dot4h(s0, pq), py1 = dot4h(s1, pq);
                    const f32x4 t0 = s0 + ck * vv0, t1 = s1 + ck * vv1;
                    float sa0 = pa0.x, sa1 = pa1.x, yp0 = py0.x, yp1 = py1.x;
                    row16_sum2_quad2(sa0, sa1, yp0, yp1, pa0.y, pa1.y, py0.y, py1.y);
                    s0 = t0 + cb * sa0; s1 = t1 + cb * sa1;
                    if (st > 0) asm volatile("ds_write_b32 %0, %1 offset:%c3\n\tds_write_b32 %0, %2 offset:%c4" :: "v"(yb), "v"(yp0), "v"(yp1), "i"((st - 1) * 512), "i"((st - 1) * 512 + 4) : "memory");
                    pq = cq; ca = na; cb = nb; ck = nk; cq = nq; na = ma; nb = mb; nk = mk; nq = mq;
                }
            }
            {
                const f32x4 py0 = s0 * pq, py1 = s1 * pq;
                float yp0 = (py0[0] + py0[1]) + (py0[2] + py0[3]), yp1 = (py1[0] + py1[1]) + (py1[2] + py1[3]);
                yp0 += dpp_f<0xB1>(yp0); yp1 += dpp_f<0xB1>(yp1); yp0 += dpp_f<0x4E>(yp0); yp1 += dpp_f<0x4E>(yp1);
                yb[(SC_CH - 1) * 128] = yp0; yb[(SC_CH - 1) * 128 + 1] = yp1;
                const f32x4 we = *(const LAS f32x4*)((const LAS float*)(lds + buf * SC_BUF + SC_COEF + SC_VT + SC_YB) + c4 * 4); s0 = s0 * we; s1 = s1 * we; }
        }
        if (helper && c + 1 < NCH) store_lds(buf ^ 1);
        __syncthreads();
        if (helper) { const LAS float* yb = (const LAS float*)(lds + buf * SC_BUF + SC_COEF + SC_VT); const int ys = ht >> 3, yp = ht & 7; const LAS float* yq = yb + ys * 128 + yp * 4;
            const f32x4 yv = (*(const LAS f32x4*)(yq) + *(const LAS f32x4*)(yq + 32)) + (*(const LAS f32x4*)(yq + 64) + *(const LAS f32x4*)(yq + 96));
            *(GAS f32x4*)(Y + base + (size_t)(c * SC_CH + ys) * RW + 32 * rh + yp * 4) = yv; }
    }
    __syncthreads();
}
__device__ __forceinline__ void rwkv_post_phase(Frame& F, const MixW& w, const float* Y, const bf16* R, const bf16* K, const float* V, const bf16* G, bf16* cat) {
    int lane = F.lane; asm volatile("" : "+v"(lane));
    const int gw = F.vcu * NWAVES + F.wave, NGW = F.G * NWAVES;
    const int hq = lane >> 4, l16 = lane & 15;
#pragma unroll 1
    for (int m = gw; m < M; m += NGW) {
        f32x4 y4[3], r4[3], k4[3], v4[3], g4[3];
#pragma unroll
        for (int it = 0; it < 3; ++it) { const int c = (4 * it + hq) * 64 + 4 * l16; const size_t o = (size_t)m * RW + c;
            y4[it] = *(const GAS f32x4*)(Y + o); r4[it] = ld4bf(R + o); k4[it] = ld4bf(K + o); v4[it] = *(const GAS f32x4*)(V + o); g4[it] = ld4bf(G + o); }
#pragma unroll
        for (int it = 0; it < 3; ++it) {
            const int c = (4 * it + hq) * 64 + 4 * l16;
            const f32x4 rk = *(const GAS f32x4*)(w.r_k + c), lw = *(const GAS f32x4*)(w.ln_w + c), lb = *(const GAS f32x4*)(w.ln_b + c);
            const float mean = row16_sum((y4[it][0] + y4[it][1]) + (y4[it][2] + y4[it][3])) * (1.f / 64.f);
            const f32x4 d = y4[it] - mean;
            const float var = row16_sum((d[0] * d[0] + d[1] * d[1]) + (d[2] * d[2] + d[3] * d[3])) * (1.f / 64.f);
            const float rstd = __builtin_amdgcn_rsqf(var + 64e-5f);
            const f32x4 rkk = r4[it] * k4[it] * rk;
            const float bon = row16_sum((rkk[0] + rkk[1]) + (rkk[2] + rkk[3]));
            const f32x4 ov = ((d * rstd) * lw + lb + v4[it] * bon) * g4[it];
            v2u ob; ob.x = pg8::cvt_pk_bf16(ov[0], ov[1]); ob.y = pg8::cvt_pk_bf16(ov[2], ov[3]);
            *(GAS v2u*)(cat + (size_t)m * D + AW + c) = ob;
        }
    }
}

#define XW ((bf16*)(ws + WS_XW))
#define H ((bf16*)(ws + WS_H))
#define CAT ((bf16*)(ws + WS_H))
#define ACT ((bf16*)(ws + WS_BIG))
#define UU ((bf16*)(ws + WS_BIG))
#define ROPC ((const float*)(ws + WS_ROPC))
#define ROPS ((const float*)(ws + WS_ROPS))
#define aQ ((bf16*)(ws + AT_Q))
#define aK ((bf16*)(ws + AT_K))
#define aV ((bf16*)(ws + AT_V))
#define aIQ ((bf16*)(ws + AT_IQ))
#define aIK ((bf16*)(ws + AT_IK))
#define aIW ((float*)(ws + AT_IW))
#define aMK ((unsigned long long*)(ws + AT_MK))
#define mR ((bf16*)(ws + MX_R))
#define mW ((float*)(ws + MX_W))
#define mKK ((bf16*)(ws + MX_KK))
#define mV ((float*)(ws + MX_V))
#define mA ((bf16*)(ws + MX_A))
#define mB ((bf16*)(ws + MX_B))
#define mG ((bf16*)(ws + MX_G))
#define mVF ((float*)(ws + MX_VF))
#define mYR ((float*)(ws + MX_YR))
#define mXBC ((bf16*)(ws + MX_XBC))
#define mDT ((float*)(ws + MX_DT))
#define sBp ((bf16*)(ws + SS_B))
#define sCp ((bf16*)(ws + SS_C))
#define sST ((float*)(ws + SS_ST))
#define sCS ((float*)(ws + SS_CS))
#define sTOT ((float*)(ws + SS_TOT))
#define mYS ((float*)(ws + MX_YS))
#define mYS2 ((float*)(ws + MX_YS2))
#define MIXW_SETUP() MixW w; \
    w.mu = (const float*)args.in[11] + (size_t)L * RC; w.w0 = (const float*)args.in[12] + (size_t)L * RW; w.w2 = (const float*)args.in[13] + (size_t)L * 64 * RW; \
    w.a0 = (const float*)args.in[14] + (size_t)L * RW; w.a2 = (const float*)args.in[15] + (size_t)L * 64 * RW; w.g2 = (const float*)args.in[16] + (size_t)L * 128 * RW; \
    w.k_k = (const float*)args.in[17] + (size_t)L * RW; w.k_a = (const float*)args.in[18] + (size_t)L * RW; w.r_k = (const float*)args.in[19] + (size_t)L * RW; \
    w.ln_w = (const float*)args.in[20] + (size_t)L * RW; w.ln_b = (const float*)args.in[21] + (size_t)L * RW; \
    w.v0 = (const float*)args.in[22]; w.v1 = (const float*)args.in[23]; w.v2 = (const float*)args.in[24]; \
    w.conv_w = (const float*)args.in[25] + (size_t)L * SCD * 4; w.conv_b = (const float*)args.in[26] + (size_t)L * SCD; w.dt_bias = (const float*)args.in[27] + (size_t)L * SH; \
    w.a_log = (const float*)args.in[28] + (size_t)L * SH; w.d_skip = (const float*)args.in[29] + (size_t)L * SH; w.norm_w = (const float*)args.in[30] + (size_t)L * SW; w.layer = L;
#define MODP ((const float*)(ws + WS_MOD) + (size_t)L * 4 * NMODC)
#define NGP ((const float*)args.in[5] + (size_t)L * 3 * D)
#define PH_BEGIN(K) if (lo <= (K) && (K) < hi) { asm volatile("" : "+v"(F.tid), "+v"(F.lane)); asm volatile("" : "+s"(F.wave), "+s"(ws), "+s"(F.G), "+s"(F.vcu)); int bid = __builtin_amdgcn_readfirstlane(blockIdx.x); asm volatile("" : "+s"(bid));
#define PH_END(K) if ((K) + 1 < hi) xcd_barrier(bar, F.tid); }
constexpr int PH_PER_LAYER = 12, PH_FINAL = 1 + 2 * PH_PER_LAYER;

template <int L, int FI> __device__ __forceinline__ void ffn_phases(Frame& F, const Args& args, unsigned char*& ws, const XcdBarrier& bar, const int lo, const int hi) {
    constexpr int K0 = 1 + L * PH_PER_LAYER + (FI == 0 ? 0 : 9);
    constexpr size_t lf = (size_t)L * 2 + FI;
    if constexpr (L == 0 && FI == 0) {
    PH_BEGIN(K0) { norm_mod_phase(F, (const float*)args.in[0], NGP, MODP, MODP + D, H); } PH_END(K0) }
    PH_BEGIN(K0 + 1) { pg8::Gemm g{H, (const bf16*)(ws + WS_WGU + lf * SZ_WGU), M, 2 * FF, D}; pg8::StaticOrder S; S.init(M, 2 * FF, F.G, bid);
        pg8::EpiSwiGLU E{ACT, FF}; pg8::gemm_phase<pg8::EpiSwiGLU, pg8::StaticOrder, true, true>(F.lds + RING_OFF, g, S, E, F.tid);
        if (bid >= 128) convert_slot(F, args, ws, 2 * L + FI, bid); } PH_END(K0 + 1)
    PH_BEGIN(K0 + 2) { constexpr bool BF = (L == 0 && FI == 0); const void* xf = BF ? (const void*)args.in[0] : (const void*)XW;
        pg8::Gemm g{ACT, (const bf16*)(ws + WS_WD + lf * SZ_WD), M, D, FF}; pg8::StaticOrder S; S.init(M, D, F.G, bid);
        if constexpr (FI == 0) {
            pg8::EpiResidNormT<false, BF> E{xf, XW, D, MODP + 2 * D, 0.5f, NGP + D, MODP + 3 * D, MODP + 4 * D, (pg8::bf16_t*)H, (float*)(ws + WS_SSQ), F.ctl + CW_PCNT + (3 * L + 0) * 32, F.ctl + CW_BAR + XB_TMO};
            pg8::gemm_phase<pg8::EpiResidNormT<false, BF>, pg8::StaticOrder, true, true>(F.lds + RING_OFF, g, S, E, F.tid);
        } else if constexpr (L == 0) {
            pg8::EpiResidNormT<false, false> E{xf, XW, D, MODP + 8 * D, 0.5f, (const float*)args.in[5] + (size_t)3 * D, (const float*)(ws + WS_MOD) + (size_t)4 * NMODC, (const float*)(ws + WS_MOD) + (size_t)4 * NMODC + D, (pg8::bf16_t*)H, (float*)(ws + WS_SSQ), F.ctl + CW_PCNT + 2 * 32, F.ctl + CW_BAR + XB_TMO};
            pg8::gemm_phase<pg8::EpiResidNormT<false, false>, pg8::StaticOrder, true, true>(F.lds + RING_OFF, g, S, E, F.tid);
        } else {
            pg8::EpiResidNormT<true, false> E{xf, args.out, D, MODP + 8 * D, 0.5f, (const float*)args.in[31], nullptr, nullptr, nullptr, (float*)(ws + WS_SSQ), F.ctl + CW_PCNT + 5 * 32, F.ctl + CW_BAR + XB_TMO};
            pg8::gemm_phase<pg8::EpiResidNormT<true, false>, pg8::StaticOrder, true, true>(F.lds + RING_OFF, g, S, E, F.tid); } } PH_END(K0 + 2)
}
template <int L> __device__ __forceinline__ void mixer_phases(Frame& F, const Args& args, unsigned char*& ws, const XcdBarrier& bar, const int lo, const int hi) {
    constexpr int K0 = 1 + L * PH_PER_LAYER + 3;
    PH_BEGIN(K0 + 1) { pg8::Gemm g{H, (const bf16*)(ws + WS_WIN + (size_t)L * SZ_WIN), M, DINP, D}; pg8::StaticOrder S; S.init(M, DINP, F.G, bid);
        pg8::EpiBf16U E{UU, DINP}; pg8::gemm_phase<pg8::EpiBf16U, pg8::StaticOrder, true, true>(F.lds + RING_OFF, g, S, E, F.tid); } PH_END(K0 + 1)
    PH_BEGIN(K0 + 2) { MIXW_SETUP()
        PrepBufs P; P.R = mR; P.Wd = mW; P.K = mKK; P.V = mV; P.A = mA; P.Bv = mB; P.G = mG; P.VF = mVF; P.XBC = mXBC; P.DT = mDT; P.sB = sBp; P.sC = sCp;
        P.Q = aQ; P.Kb = aK; P.Vb = aV; P.IQ = aIQ; P.IK = aIK; P.IW = aIW; P.rc = ROPC; P.rs = ROPS; P.lw = (const bf16*)(ws + WS_LW) + (size_t)L * LW_ELEMS;
        for (int u_ = bid; u_ < M / 32; u_ += F.G) { int un = __builtin_amdgcn_readfirstlane(u_); asm volatile("" : "+s"(un)); prep_unit(F, un, UU, w, P); } }
    PH_END(K0 + 2)
    PH_BEGIN(K0 + 3) { MIXW_SETUP()
        constexpr int NSCAN = 96;
        if (bid < NSCAN) { rwkv_scan_unit(F, bid, mR, mW, mKK, (L == 0 ? mVF : mV), mA, mB, mYR); }
        else {
            const int nb = F.G - NSCAN, rb = bid - NSCAN;
            for (int u_ = rb; u_ < 512; u_ += nb) { int un = __builtin_amdgcn_readfirstlane(u_); asm volatile("" : "+s"(un)); idx_unit(F, un, aIQ, aIK, aIW, aMK); }
            for (int u_ = rb; u_ < 128; u_ += nb) { int un = __builtin_amdgcn_readfirstlane(u_); asm volatile("" : "+s"(un)); ssd_pass1_unit(F, un, mXBC, mDT, sBp, sCp, w.a_log, mYS, sST, sCS, sTOT); }
            group_barrier(F.ctl + 2048 + 64 * L, (unsigned)nb, F.ctl + CW_BAR + XB_TMO, F.tid);
            for (int k_ = rb; k_ < 144; k_ += nb) {
                const int k = __builtin_amdgcn_readfirstlane(k_);
                int bh0, q0_, bh1, q1_;
                if (k < 128) { bh0 = k >> 2; bh1 = bh0; const int j = k & 3; q0_ = 7 - j; q1_ = (j == 0) ? -1 : j - 1; }
                else { bh0 = 2 * (k - 128); bh1 = bh0 + 1; q0_ = 3; q1_ = 3; }
                attn_body::attn_unit<8>(bh0 >> 3, bh0 & 7, q0_, (const attn_body::bf16*)aQ, (const attn_body::bf16*)aK, (const attn_body::bf16*)aV, (attn_body::bf16*)CAT, aMK + (size_t)(bh0 >> 3) * 32 * T, F.ldsg, F.tid);
                if (q1_ >= 0) attn_body::attn_unit<8>(bh1 >> 3, bh1 & 7, q1_, (const attn_body::bf16*)aQ, (const attn_body::bf16*)aK, (const attn_body::bf16*)aV, (attn_body::bf16*)CAT, aMK + (size_t)(bh1 >> 3) * 32 * T, F.ldsg, F.tid);
            }
        } }
    PH_END(K0 + 3)
    PH_BEGIN(K0 + 4) { MIXW_SETUP()
        if (bid < 128) ssd_pass2_unit(F, bid, mXBC, UU, sCp, mYS, sST, sCS, sTOT, w.d_skip, w.norm_w, CAT);
        rwkv_post_phase(F, w, mYR, mR, mKK, (L == 0 ? mVF : mV), mG, CAT); }
    PH_END(K0 + 4)
    PH_BEGIN(K0 + 5) { pg8::Gemm g{CAT, (const bf16*)(ws + WS_WOUT + (size_t)L * SZ_WOUT), M, D, D}; pg8::StaticOrder S; S.init(M, D, F.G, bid);
        pg8::EpiResidNormT<false, false> E{XW, XW, D, MODP + 5 * D, 1.0f, NGP + 2 * D, MODP + 6 * D, MODP + 7 * D, (pg8::bf16_t*)H, (float*)(ws + WS_SSQ), F.ctl + CW_PCNT + (3 * L + 1) * 32, F.ctl + CW_BAR + XB_TMO};
        pg8::gemm_phase<pg8::EpiResidNormT<false, false>, pg8::StaticOrder, true, true>(F.lds + RING_OFF, g, S, E, F.tid); } PH_END(K0 + 5)
}

__global__ void __launch_bounds__(NTHR, 2) fwd(Args args) {
    extern __shared__ __attribute__((aligned(16))) unsigned char lds[];
    Frame F;
    F.lds = (LAS unsigned char*)lds; F.ldsg = (char*)lds; F.MISC = (volatile LAS unsigned*)(F.lds + MISC_OFF);
    F.tid = threadIdx.x; F.lane = F.tid & 63; F.wave = __builtin_amdgcn_readfirstlane(F.tid >> 6);
    F.G = gridDim.x; { const int bx = blockIdx.x; F.vcu = (F.G % 8 == 0) ? (bx % 8) * (F.G / 8) + bx / 8 : bx; }
    unsigned char* ws = args.ws;
    F.ctl = (unsigned*)(ws + WS_CTL);
    for (int u = F.tid; u < (LDS_BYTES - LDSCTL_OFF) / 4; u += NTHR) ((LAS unsigned*)(F.lds + LDSCTL_OFF))[u] = 0u;
    __syncthreads();
    XcdBarrier bar = xcd_barrier_post(F.ctl + CW_BAR, F.MISC + 8, F.tid);
    const int lo = args.ph_lo, hi = args.ph_hi;
    PH_BEGIN(0) p0_prologue(F, args); PH_END(0)
    ffn_phases<0, 0>(F, args, ws, bar, lo, hi);
    mixer_phases<0>(F, args, ws, bar, lo, hi);
    ffn_phases<0, 1>(F, args, ws, bar, lo, hi);
    ffn_phases<1, 0>(F, args, ws, bar, lo, hi);
    mixer_phases<1>(F, args, ws, bar, lo, hi);
    ffn_phases<1, 1>(F, args, ws, bar, lo, hi);
}

extern "C" void kernel_launch(void* const* d_in, const int* in_sizes, int n_in, void* d_out, int out_size, void* d_ws, size_t ws_size, hipStream_t stream) {
    static int grid = 0;
    if (grid == 0) {
        if (n_in != 32 || out_size != M * D || ws_size < WS_END) { fprintf(stderr, "kernel_launch: unexpected problem: n_in %d out %d ws %zu (need %zu)\n", n_in, out_size, ws_size, (size_t)WS_END); grid = -1; return; }
        int dev = 0, cus = 0, per_cu = 0;
        if (hipGetDevice(&dev) != hipSuccess || hipDeviceGetAttribute(&cus, hipDeviceAttributeMultiprocessorCount, dev) != hipSuccess) { grid = -1; return; }
        if (hipFuncSetAttribute((const void*)fwd, hipFuncAttributeMaxDynamicSharedMemorySize, LDS_BYTES) != hipSuccess) { fprintf(stderr, "kernel_launch: hipFuncSetAttribute failed\n"); grid = -1; return; }
        if (hipOccupancyMaxActiveBlocksPerMultiprocessor(&per_cu, (const void*)fwd, NTHR, LDS_BYTES) != hipSuccess || per_cu < 1) fprintf(stderr, "kernel_launch: occupancy query says %d\n", per_cu);
        (void)hipGetLastError();
        if (cus != 256) { fprintf(stderr, "kernel_launch: this kernel is laid out for 256 CUs (one 256x256 unit per workgroup in the fused residual epilogues), found %d\n", cus); grid = -1; return; }
        grid = cus;
    }
    if (grid < 0) return;
    (void)hipMemsetAsync((char*)d_ws + WS_CTL, 0, 32768, stream);
    Args a{};
    for (int i = 0; i < 32; ++i) a.in[i] = d_in[i];
    a.out = (float*)d_out; a.ws = (unsigned char*)d_ws; a.ph_lo = 0; a.ph_hi = PH_FINAL;
    hipLaunchKernelGGL(fwd, dim3(grid), dim3(NTHR), LDS_BYTES, stream, a);
}
```
